# Optimizing an MI355X kernel written in HIP

```python
import jax, jax.numpy as jnp
from jax import lax
import numpy as np

D_MODEL = 1024
BATCH = 16
SEQ = 4096
DEPTH = 2
DEC_BATCH = 16
DEC_SEQ = 32
PAST_LEN = 1024

CHUNK = 64
D_POOL = D_MODEL // 4
POOL_WINDOWS = (2, 4, 8, 16)
N_POOL_GROUPS = len(POOL_WINDOWS)
POOL_GROUP = D_POOL // N_POOL_GROUPS
POOL_MAX = max(POOL_WINDOWS)
POOL_HIST = POOL_MAX - 1
D_RWKV = D_MODEL - D_POOL
HEAD_DIM = 64
N_HEADS = D_RWKV // HEAD_DIM
LORA_W = 64
LORA_A = 64
LORA_G = 128
D_SHIFT = 3 * D_RWKV + LORA_W + LORA_A + LORA_G
N_IN = D_POOL + D_SHIFT
RWKV_SPLITS = (D_RWKV, 2 * D_RWKV, 3 * D_RWKV, 3 * D_RWKV + LORA_W, 3 * D_RWKV + LORA_W + LORA_A)
D_FF = 2816
D_PLE = 256
ALPHA = (2.0 * DEPTH) ** 0.25
BETA = (8.0 * DEPTH) ** -0.25
LN_EPS = 1e-5
LNX_EPS = 64e-5

kernel_name = "pool_rwkv7_macaron_deepnorm_stream"


def layer_norm(x, g, b, eps=LN_EPS):
    xf = x.astype(jnp.float32)
    mu = jnp.mean(xf, axis=-1, keepdims=True)
    var = jnp.mean(jnp.square(xf - mu), axis=-1, keepdims=True)
    return ((xf - mu) * lax.rsqrt(var + eps) * g.astype(jnp.float32) + b.astype(jnp.float32)).astype(x.dtype)


def swiglu(x, w_in, w_out):
    gate, up = jnp.split(x @ w_in, 2, axis=-1)
    return (jax.nn.silu(gate) * up) @ w_out


def pool_mixer(u, u_hist, pos0, pool_w, pool_scale):
    B, T, _ = u.shape
    H = u_hist.shape[1]
    u_ext = jnp.concatenate([u_hist, u], axis=1)
    padded = jnp.pad(u_ext.astype(jnp.float32), ((0, 0), (POOL_MAX, 0), (0, 0)))
    cs = jnp.cumsum(padded, axis=1)
    end = cs[:, H + POOL_MAX:H + POOL_MAX + T]
    pos = pos0 + jnp.arange(T)
    means = []
    for gi, w in enumerate(POOL_WINDOWS):
        sl = slice(gi * POOL_GROUP, (gi + 1) * POOL_GROUP)
        s = end[..., sl] - cs[:, H + POOL_MAX - w:H + POOL_MAX - w + T, sl]
        cnt = jnp.minimum(pos + 1, w).astype(jnp.float32)[None, :, None]
        means.append(s / cnt)
    pooled = jnp.concatenate(means, axis=-1).astype(u.dtype) - u
    mixed = jnp.einsum('btgc,gcd->btgd', pooled.reshape(B, T, N_POOL_GROUPS, POOL_GROUP), pool_w)
    out = mixed.reshape(B, T, D_POOL) * pool_scale
    return out, u_ext[:, -POOL_HIST:]


def wkv_step(S, inp):
    r_t, w_t, k_t, v_t, a_t, b_t = inp
    sa = jnp.einsum('bhvk,bhk->bhv', S, a_t)
    S = S * w_t[:, :, None, :] + sa[..., None] * b_t[:, :, None, :] + v_t[..., None] * k_t[:, :, None, :]
    y = jnp.einsum('bhvk,bhk->bhv', S, r_t)
    return S, y


def rwkv7_mixer(zr, shift_prev, wkv_prev, mu_shift, w0, w2, a0, a2, g2, k_k, k_a, r_k, lnx_g, lnx_b):
    B, T, _ = zr.shape
    z_prev = jnp.concatenate([shift_prev[:, None, :], zr[:, :-1]], axis=1)
    zs = zr + (z_prev - zr) * mu_shift
    r, k, v, lw, la, lg = jnp.split(zs, RWKV_SPLITS, axis=-1)
    w = -jax.nn.softplus(-(w0 + jnp.tanh(lw) @ w2)) - 0.5
    decay = jnp.exp(-jnp.exp(w.astype(jnp.float32)))
    a = jax.nn.sigmoid(a0 + la @ a2)
    g = jax.nn.sigmoid(lg) @ g2

    def heads(t):
        return t.reshape(B, T, N_HEADS, HEAD_DIM).astype(jnp.float32)

    kk = heads(k * k_k)
    kk = kk / jnp.maximum(jnp.sqrt(jnp.sum(kk * kk, axis=-1, keepdims=True)), 1e-12)
    k = k * (1 + (a - 1) * k_a)
    rh, kh, vh, ah, wh = heads(r), heads(k), heads(v), heads(a), heads(decay)
    bh = kk * ah

    def tm(t):
        return jnp.moveaxis(t, 1, 0)

    S_final, ys = lax.scan(wkv_step, wkv_prev.astype(jnp.float32),
                           (tm(rh), tm(wh), tm(kh), tm(vh), tm(-kk), tm(bh)))
    ys = jnp.moveaxis(ys, 0, 1)
    ys = layer_norm(ys, lnx_g.reshape(N_HEADS, HEAD_DIM), lnx_b.reshape(N_HEADS, HEAD_DIM), LNX_EPS)
    ys = ys + jnp.sum(rh * kh * r_k.astype(jnp.float32), axis=-1, keepdims=True) * vh
    out = ys.reshape(B, T, D_RWKV).astype(zr.dtype) * g
    return out, zr[:, -1], S_final.astype(wkv_prev.dtype)


def run_trunk(x, p, pos0, pool_hist, shift_prev, wkv_prev, W):
    pools, shifts, wkvs = [], [], []
    for i in range(DEPTH):
        x = layer_norm(ALPHA * x + 0.5 * swiglu(x, W['ffn1_w_in'][i], W['ffn1_w_out'][i]),
                       W['ln1_g'][i], W['ln1_b'][i])
        z = x @ W['w_in'][i]
        u, zr = z[..., :D_POOL], z[..., D_POOL:]
        pool_out, pool_new = pool_mixer(u, pool_hist[i], pos0, W['pool_w'][i], W['pool_scale'][i])
        rwkv_out, shift_new, wkv_new = rwkv7_mixer(
            zr, shift_prev[i], wkv_prev[i], W['mu_shift'][i], W['w0'][i], W['w2'][i], W['a0'][i],
            W['a2'][i], W['g2'][i], W['k_k'][i], W['k_a'][i], W['r_k'][i], W['lnx_g'][i], W['lnx_b'][i])
        mix = jnp.concatenate([pool_out, rwkv_out], axis=-1) @ W['w_out'][i]
        x = layer_norm(ALPHA * x + mix, W['ln2_g'][i], W['ln2_b'][i])
        h = ALPHA * x + 0.5 * swiglu(x, W['ffn2_w_in'][i], W['ffn2_w_out'][i])
        gate = jax.nn.sigmoid(h @ W['ple_gate_w'][i] + W['ple_gate_b'][i])
        h = h + gate * (p[i] @ W['ple_w'][i])
        x = layer_norm(h, W['ln3_g'][i], W['ln3_b'][i])
        pools.append(pool_new)
        shifts.append(shift_new)
        wkvs.append(wkv_new)
    return x, jnp.stack(pools), jnp.stack(shifts), jnp.stack(wkvs)


def setup_inputs(seed: int = 0) -> dict:
    key = jax.random.key(seed)
    ks = iter(jax.random.split(key, 48))
    f32 = jnp.float32

    def nrm(shape, scale):
        return jax.random.normal(next(ks), shape, f32) * scale

    def gain(shape):
        return 1.0 + nrm(shape, 0.05)

    L = DEPTH
    w0_base = jnp.tile(jnp.linspace(-6.0, 1.0, HEAD_DIM, dtype=f32), N_HEADS)
    return {
        "x_prompt": nrm((BATCH, SEQ, D_MODEL), 1.0),
        "x_sample": nrm((DEC_BATCH, DEC_SEQ, D_MODEL), 1.0),
        "p_prompt": nrm((DEPTH, BATCH, SEQ, D_PLE), 1.0),
        "p_sample": nrm((DEPTH, DEC_BATCH, DEC_SEQ, D_PLE), 1.0),
        "state_pool": nrm((DEPTH, DEC_BATCH, POOL_HIST, D_POOL), 1.0),
        "state_shift": nrm((DEPTH, DEC_BATCH, D_SHIFT), 1.0),
        "state_wkv": nrm((DEPTH, DEC_BATCH, N_HEADS, HEAD_DIM, HEAD_DIM), 0.3),
        "ln1_g": gain((L, D_MODEL)), "ln1_b": nrm((L, D_MODEL), 0.02),
        "ln2_g": gain((L, D_MODEL)), "ln2_b": nrm((L, D_MODEL), 0.02),
        "ln3_g": gain((L, D_MODEL)), "ln3_b": nrm((L, D_MODEL), 0.02),
        "ffn1_w_in": nrm((L, D_MODEL, 2 * D_FF), D_MODEL ** -0.5),
        "ffn1_w_out": nrm((L, D_FF, D_MODEL), BETA * D_FF ** -0.5),
        "ffn2_w_in": nrm((L, D_MODEL, 2 * D_FF), D_MODEL ** -0.5),
        "ffn2_w_out": nrm((L, D_FF, D_MODEL), BETA * D_FF ** -0.5),
        "w_in": nrm((L, D_MODEL, N_IN), D_MODEL ** -0.5),
        "mu_shift": jax.random.uniform(next(ks), (L, D_SHIFT), f32, 0.05, 0.95),
        "pool_w": nrm((L, N_POOL_GROUPS, POOL_GROUP, POOL_GROUP), POOL_GROUP ** -0.5),
        "pool_scale": gain((L, D_POOL)),
        "w0": w0_base[None, :] + nrm((L, D_RWKV), 0.1),
        "w2": nrm((L, LORA_W, D_RWKV), 0.1 * LORA_W ** -0.5),
        "a0": nrm((L, D_RWKV), 0.1),
        "a2": nrm((L, LORA_A, D_RWKV), 0.3 * LORA_A ** -0.5),
        "g2": nrm((L, LORA_G, D_RWKV), LORA_G ** -0.5),
        "k_k": 0.85 + nrm((L, D_RWKV), 0.05),
        "k_a": gain((L, D_RWKV)),
        "r_k": nrm((L, N_HEADS, HEAD_DIM), 0.1),
        "lnx_g": gain((L, D_RWKV)), "lnx_b": nrm((L, D_RWKV), 0.02),
        "w_out": nrm((L, D_MODEL, D_MODEL), BETA * D_MODEL ** -0.5),
        "ple_gate_w": nrm((L, D_MODEL, D_MODEL), D_MODEL ** -0.5),
        "ple_gate_b": nrm((L, D_MODEL), 0.02),
        "ple_w": nrm((L, D_PLE, D_MODEL), BETA * D_PLE ** -0.5),
    }


def reference(x_prompt, x_sample, p_prompt, p_sample, state_pool, state_shift, state_wkv,
              ln1_g, ln1_b, ln2_g, ln2_b, ln3_g, ln3_b,
              ffn1_w_in, ffn1_w_out, ffn2_w_in, ffn2_w_out,
              w_in, mu_shift, pool_w, pool_scale, w0, w2, a0, a2, g2, k_k, k_a, r_k,
              lnx_g, lnx_b, w_out, ple_gate_w, ple_gate_b, ple_w):
    W = dict(ln1_g=ln1_g, ln1_b=ln1_b, ln2_g=ln2_g, ln2_b=ln2_b, ln3_g=ln3_g, ln3_b=ln3_b,
             ffn1_w_in=ffn1_w_in, ffn1_w_out=ffn1_w_out, ffn2_w_in=ffn2_w_in, ffn2_w_out=ffn2_w_out,
             w_in=w_in, mu_shift=mu_shift, pool_w=pool_w, pool_scale=pool_scale, w0=w0, w2=w2,
             a0=a0, a2=a2, g2=g2, k_k=k_k, k_a=k_a, r_k=r_k, lnx_g=lnx_g, lnx_b=lnx_b,
             w_out=w_out, ple_gate_w=ple_gate_w, ple_gate_b=ple_gate_b, ple_w=ple_w)
    B = x_prompt.shape[0]
    dt = x_prompt.dtype
    y_prompt, pool_prompt, shift_prompt, wkv_prompt = run_trunk(
        x_prompt, p_prompt, 0,
        jnp.zeros((DEPTH, B, 0, D_POOL), dt),
        jnp.zeros((DEPTH, B, D_SHIFT), dt),
        jnp.zeros((DEPTH, B, N_HEADS, HEAD_DIM, HEAD_DIM), dt), W)
    y_sample, pool_sample, shift_sample, wkv_sample = run_trunk(
        x_sample, p_sample, PAST_LEN, state_pool, state_shift, state_wkv, W)
    return (y_prompt, y_sample, pool_prompt, shift_prompt, wkv_prompt, pool_sample, shift_sample, wkv_sample)
```

```cpp
#include <hip/hip_runtime.h>
#include <hip/hip_cooperative_groups.h>
#include <cstdio>
namespace cg = cooperative_groups;
namespace pg8 {
#define PG8_LAS __attribute__((address_space(3)))
typedef unsigned short bf16_t;
typedef short bf16x8 __attribute__((ext_vector_type(8)));
typedef float f32x4 __attribute__((ext_vector_type(4)));
typedef unsigned u32x4 __attribute__((ext_vector_type(4)));
constexpr int BM = 256, BK = 64, HALF = 128, HTB = HALF * BK * 2  , STAGE_BYTES = 8 * HTB, NXCD = 8, WGM = 8;

__host__ __device__ __forceinline__ int lds_byte(int r, int c) { const int st = (r >> 4) * 2 + (c >> 5), rr = r & 15, cc = c & 31, ob = rr * 64 + cc * 2; return st * 1024 + (ob ^ (((ob >> 9) & 1) << 5)); }
__host__ __device__ __forceinline__ void stage_rc(int b, int& R, int& C) { const int st = b / 1024, sb = b % 1024, swz = sb ^ (((sb >> 9) & 1) << 5); R = (st >> 1) * 16 + swz / 64; C = (st & 1) * 32 + (swz % 64) / 2; }
__host__ __device__ __forceinline__ int perm32(int rho) { const int n = rho >> 4, i = rho & 15; return 8 * (i >> 2) + 4 * n + (i & 3); }

struct Unit { int pm, pn; };
struct Gemm { const bf16_t* A; const bf16_t* Bt; int M, N, K; };

struct StaticOrder {
    int nM, nN, nwg, G, c;
    __host__ __device__ void init(int M, int N, int G_, int c_) { nM = M / BM; nN = N / BM; nwg = nM * nN; G = G_; c = c_; }
    __host__ __device__ bool next(int i, Unit& u) const {
        const long L = (long)i * G + c; if (L >= nwg) return false;
        int wgid = (int)L; { const int q = nwg / NXCD, r = nwg % NXCD, xcd = wgid % NXCD, off = wgid / NXCD; wgid = (xcd < r ? xcd * (q + 1) : r * (q + 1) + (xcd - r) * q) + off; }
        const int nig = WGM * nN, gid = wgid / nig, fm = gid * WGM, gsz = (nM - fm) < WGM ? (nM - fm) : WGM;
        u.pm = fm + ((wgid % nig) % gsz); u.pn = (wgid % nig) / gsz; return true;
    }
    __device__ __forceinline__ void a_ready(const Unit&) const {}
    __device__ __forceinline__ void done(const Unit&) const {}
};
__device__ __forceinline__ unsigned cvt_pk_bf16(float lo, float hi) { unsigned r; asm volatile("v_cvt_pk_bf16_f32 %0, %1, %2" : "=v"(r) : "v"(lo), "v"(hi)); return r; }
typedef float f32x2 __attribute__((ext_vector_type(2)));
typedef unsigned u32x2 __attribute__((ext_vector_type(2)));
__device__ __forceinline__ float fast_sigmoid(float x) { return __builtin_amdgcn_rcpf(1.0f + __builtin_amdgcn_exp2f(-1.4426950408889634f * x)); }

struct EpiSwiglu {
    static constexpr bool PERM = true, AFTER_DRAIN = false;
    bf16_t* H; int ldh;
    __device__ __forceinline__ void operator()(const f32x4 (&acc)[2][2][4][2], const Unit& u, int wr, int wc, int fr, int fq) const {
        const int row0 = u.pm * BM + wr * 64 + fr, col0 = u.pn * HALF + wc * 32 + 8 * fq;
#pragma unroll
        for (int ai = 0; ai < 2; ++ai)
#pragma unroll
            for (int m = 0; m < 4; ++m) {
                bf16_t* rowp = H + (size_t)(row0 + ai * HALF + m * 16) * ldh + col0;
                float h[8];
#pragma unroll
                for (int n = 0; n < 2; ++n)
#pragma unroll
                    for (int j = 0; j < 4; ++j) { const float g = acc[ai][0][m][n][j], up = acc[ai][1][m][n][j]; h[n * 4 + j] = g * fast_sigmoid(g) * up; }
                u32x4 w; w.x = cvt_pk_bf16(h[0], h[1]); w.y = cvt_pk_bf16(h[2], h[3]); w.z = cvt_pk_bf16(h[4], h[5]); w.w = cvt_pk_bf16(h[6], h[7]);
                *(u32x4*)rowp = w;
            }
    }
};
struct EpiStoreBf16 {
    static constexpr bool PERM = true, AFTER_DRAIN = false;
    bf16_t* O; int ldc; const float* cscale;
    __device__ __forceinline__ void operator()(const f32x4 (&acc)[2][2][4][2], const Unit& u, int wr, int wc, int fr, int fq) const {
        const int row0 = u.pm * BM + wr * 64 + fr, col0 = u.pn * BM + wc * 32 + 8 * fq;
        f32x4 sc[2][2];
#pragma unroll
        for (int bj = 0; bj < 2; ++bj)
#pragma unroll
            for (int n = 0; n < 2; ++n) sc[bj][n] = cscale ? *(const f32x4*)(cscale + col0 + bj * HALF + 4 * n) : (f32x4){1.f, 1.f, 1.f, 1.f};
#pragma unroll
        for (int ai = 0; ai < 2; ++ai)
#pragma unroll
            for (int m = 0; m < 4; ++m) { bf16_t* rowp = O + (size_t)(row0 + ai * HALF + m * 16) * ldc + col0;
#pragma unroll
                for (int bj = 0; bj < 2; ++bj) { const f32x4 v0 = acc[ai][bj][m][0] * sc[bj][0], v1 = acc[ai][bj][m][1] * sc[bj][1];
                    u32x4 w; w.x = cvt_pk_bf16(v0[0], v0[1]); w.y = cvt_pk_bf16(v0[2], v0[3]); w.z = cvt_pk_bf16(v1[0], v1[1]); w.w = cvt_pk_bf16(v1[2], v1[3]);
                    *(u32x4*)(rowp + bj * HALF) = w; } }
    }
};
struct EpiResid {
    static constexpr bool PERM = false, AFTER_DRAIN = false;
    const float* srcA; const float* srcB; int split_row; float* out; bf16_t* ob; int ldc; float sa, sb;
    __device__ __forceinline__ void operator()(const f32x4 (&acc)[2][2][4][2], const Unit& u, int wr, int wc, int fr, int fq) const {
        const int row0 = u.pm * BM + wr * 64 + fr, col0 = u.pn * BM + wc * 32 + 4 * fq;
        const float* src = (u.pm * BM >= split_row) ? srcB : srcA;
#pragma unroll
        for (int ai = 0; ai < 2; ++ai)
#pragma unroll
            for (int m = 0; m < 4; ++m) { const size_t off = (size_t)(row0 + ai * HALF + m * 16) * ldc + col0;
#pragma unroll
                for (int bj = 0; bj < 2; ++bj)
#pragma unroll
                    for (int n = 0; n < 2; ++n) { const f32x4 s = *(const f32x4*)(src + off + bj * HALF + n * 16); const f32x4 o = s * sa + acc[ai][bj][m][n] * sb;
                        *(f32x4*)(out + off + bj * HALF + n * 16) = o;
                        if (ob) { u32x2 w; w.x = cvt_pk_bf16(o[0], o[1]); w.y = cvt_pk_bf16(o[2], o[3]); *(u32x2*)(ob + off + bj * HALF + n * 16) = w; } }
                asm volatile("" ::: "memory"); }
    }
};
struct EpiGate {
    static constexpr bool PERM = false, AFTER_DRAIN = false;
    float* R; const bf16_t* PP; const float* bias; int ldc;
    __device__ __forceinline__ void operator()(const f32x4 (&acc)[2][2][4][2], const Unit& u, int wr, int wc, int fr, int fq) const {
        const int row0 = u.pm * BM + wr * 64 + fr, col0 = u.pn * BM + wc * 32 + 4 * fq;
        f32x4 bv[2][2];
#pragma unroll
        for (int bj = 0; bj < 2; ++bj)
#pragma unroll
            for (int n = 0; n < 2; ++n) bv[bj][n] = *(const f32x4*)(bias + col0 + bj * HALF + n * 16);
#pragma unroll
        for (int ai = 0; ai < 2; ++ai)
#pragma unroll
            for (int m = 0; m < 4; ++m) { const size_t off = (size_t)(row0 + ai * HALF + m * 16) * ldc + col0;
#pragma unroll
                for (int bj = 0; bj < 2; ++bj)
#pragma unroll
                    for (int n = 0; n < 2; ++n) { const size_t o2 = off + bj * HALF + n * 16; const f32x4 s = *(const f32x4*)(R + o2); const u32x2 pw = *(const u32x2*)(PP + o2);
                        const f32x4 a = acc[ai][bj][m][n] + bv[bj][n]; f32x4 o;
                        o[0] = s[0] + fast_sigmoid(a[0]) * __uint_as_float(pw.x << 16); o[1] = s[1] + fast_sigmoid(a[1]) * __uint_as_float(pw.x & 0xffff0000u);
                        o[2] = s[2] + fast_sigmoid(a[2]) * __uint_as_float(pw.y << 16); o[3] = s[3] + fast_sigmoid(a[3]) * __uint_as_float(pw.y & 0xffff0000u);
                        *(f32x4*)(R + o2) = o; }
                asm volatile("" ::: "memory"); }
    }
};
template <class Epi, class Sched, bool STAMP = false>
__device__ __forceinline__ void gemm_phase(PG8_LAS unsigned char* lds, const Gemm g, const Sched& S, const Epi& E, unsigned long long* stamps) {
    int tid_l = threadIdx.x; asm volatile("" : "+v"(tid_l));
    const int tid = tid_l, wid = __builtin_amdgcn_readfirstlane(tid >> 6), lane = tid & 63, wr = wid >> 2, wc = wid & 3, fr = lane & 15, fq = lane >> 4;
    const int K = g.K, nt = K / BK;
    int ts_lo = 0, ts_hi = 0, nts = 0; const unsigned long long rt_entry = STAMP ? (unsigned long long)wall_clock64() : 0ull;
#define PG8_STAMP() do { if (STAMP && wid == 0 && nts < 64) { const unsigned long long _c = (unsigned long long)clock64(); \
        ts_lo = (lane == nts) ? (int)(unsigned)_c : ts_lo; ts_hi = (lane == nts) ? (int)(unsigned)(_c >> 32) : ts_hi; ++nts; } } while (0)
    PG8_STAMP();
    unsigned voffA[2], voffB[2];
#pragma unroll
    for (int i = 0; i < 2; ++i) { int R, C; stage_rc(tid * 16 + i * 8192, R, C); const int Rb = Epi::PERM ? ((R & ~31) + perm32(R & 31)) : R;
        voffA[i] = (unsigned)(R * K + C) * 2u; voffB[i] = (unsigned)(Rb * K + C) * 2u; }
    const size_t kstep = (size_t)(BK * 2);
    const size_t hstep = (size_t)HALF * K * 2;
    const size_t tstep = 2 * hstep;
    const unsigned ldsw = (unsigned)wid * 1024u;
    const int aoff = lds_byte(wr * 64 + fr, fq * 8), boff = lds_byte(wc * 32 + fr, fq * 8);
#define PG8_SA(b, h) (((b) * 2 + (h)) * HTB)
#define PG8_SB(b, h) ((4 + (b) * 2 + (h)) * HTB)
#define PG8_STAGE(bufoff, gbase, voff) do { _Pragma("unroll") for (int _i = 0; _i < 2; ++_i) \
        __builtin_amdgcn_global_load_lds((const unsigned*)((const char*)(gbase) + (voff)[_i]), (PG8_LAS unsigned*)(lds + (bufoff) + ldsw + _i * 8192), 16, 0, 0); } while (0)
#define PG8_LDA(dst, b, h) do { _Pragma("unroll") for (int m = 0; m < 4; ++m) _Pragma("unroll") for (int k = 0; k < 2; ++k) dst[m][k] = *(const PG8_LAS bf16x8*)(lds + PG8_SA(b, h) + aoff + m * 2048 + k * 1024); } while (0)
#define PG8_LDB(dst, b, h) do { _Pragma("unroll") for (int n = 0; n < 2; ++n) _Pragma("unroll") for (int k = 0; k < 2; ++k) dst[n][k] = *(const PG8_LAS bf16x8*)(lds + PG8_SB(b, h) + boff + n * 2048 + k * 1024); } while (0)
#define PG8_MMA(ai, bj, At, Bt) do { __builtin_amdgcn_s_setprio(1); _Pragma("unroll") for (int m = 0; m < 4; ++m) _Pragma("unroll") for (int n = 0; n < 2; ++n) _Pragma("unroll") for (int k = 0; k < 2; ++k) \
        acc[ai][bj][m][n] = __builtin_amdgcn_mfma_f32_16x16x32_bf16(Bt[n][k], At[m][k], acc[ai][bj][m][n], 0, 0, 0); __builtin_amdgcn_s_setprio(0); } while (0)
#define PG8_WAIT_V(n) asm volatile("s_waitcnt vmcnt(" #n ")" ::: "memory")
#define PG8_WAIT_L(n) asm volatile("s_waitcnt lgkmcnt(" #n ")" ::: "memory")
#define PG8_BAR __builtin_amdgcn_s_barrier()
#define PG8_SCHED __builtin_amdgcn_sched_barrier(0)
    Unit cur, nxt; int ui = 0;
    if (!S.next(0, cur)) return;
    f32x4 acc[2][2][4][2];
#pragma unroll
    for (int a = 0; a < 2; ++a)
#pragma unroll
        for (int b = 0; b < 2; ++b)
#pragma unroll
            for (int m = 0; m < 4; ++m)
#pragma unroll
                for (int n = 0; n < 2; ++n) acc[a][b][m][n] = (f32x4){0.f, 0.f, 0.f, 0.f};
    bf16x8 At[4][2], B0[2][2], B1[2][2];
    const char* cA = (const char*)g.A + (size_t)cur.pm * tstep; const char* cB = (const char*)g.Bt + (size_t)cur.pn * tstep;
    S.a_ready(cur);
    PG8_STAGE(PG8_SB(0, 0), cB, voffB); PG8_STAGE(PG8_SA(0, 0), cA, voffA); PG8_STAGE(PG8_SB(0, 1), cB + hstep, voffB); PG8_STAGE(PG8_SA(0, 1), cA + hstep, voffA);
    if (wr == 1) PG8_BAR;
    PG8_WAIT_V(4); PG8_BAR;
    PG8_STAGE(PG8_SB(1, 0), cB + kstep, voffB); PG8_STAGE(PG8_SA(1, 0), cA + kstep, voffA); PG8_STAGE(PG8_SB(1, 1), cB + hstep + kstep, voffB);
    PG8_WAIT_V(6); PG8_BAR;
    PG8_STAMP();
    for (;;) {
        const bool has_next = S.next(ui + 1, nxt);
        const char* nA = has_next ? (const char*)g.A + (size_t)nxt.pm * tstep : cA; const char* nB = has_next ? (const char*)g.Bt + (size_t)nxt.pn * tstep : cB;
        for (int t = 0; t < nt; t += 2) {
            const bool last = (t == nt - 2);
            const char* a1 = cA + (size_t)(t + 1) * kstep;
            const char* a2 = last ? nA : cA + (size_t)(t + 2) * kstep; const char* b2 = last ? nB : cB + (size_t)(t + 2) * kstep;
            const char* a3 = a2 + kstep; const char* b3 = b2 + kstep;
            if (last && has_next) S.a_ready(nxt);
            PG8_LDB(B0, 0, 0); PG8_SCHED; PG8_LDA(At, 0, 0); PG8_STAGE(PG8_SA(1, 1), a1 + hstep, voffA);
            PG8_WAIT_L(8); PG8_BAR; PG8_WAIT_L(0); PG8_MMA(0, 0, At, B0); PG8_BAR; PG8_SCHED;
            PG8_LDB(B1, 0, 1); PG8_STAGE(PG8_SB(0, 0), b2, voffB);
            PG8_BAR; PG8_WAIT_L(0); PG8_MMA(0, 1, At, B1); PG8_BAR;
            PG8_LDA(At, 0, 1); PG8_STAGE(PG8_SA(0, 0), a2, voffA);
            PG8_BAR; PG8_WAIT_L(0); PG8_MMA(1, 0, At, B0); PG8_BAR; PG8_SCHED;
            PG8_STAGE(PG8_SB(0, 1), b2 + hstep, voffB);
            PG8_WAIT_V(6); PG8_BAR; PG8_MMA(1, 1, At, B1); PG8_BAR;
            PG8_LDB(B0, 1, 0); PG8_SCHED; PG8_LDA(At, 1, 0); PG8_STAGE(PG8_SA(0, 1), a2 + hstep, voffA);
            PG8_WAIT_L(8); PG8_BAR; PG8_WAIT_L(0); PG8_MMA(0, 0, At, B0); PG8_BAR; PG8_SCHED;
            PG8_LDB(B1, 1, 1); PG8_STAGE(PG8_SB(1, 0), b3, voffB);
            PG8_BAR; PG8_WAIT_L(0); PG8_MMA(0, 1, At, B1); PG8_BAR;
            PG8_LDA(At, 1, 1); PG8_STAGE(PG8_SA(1, 0), a3, voffA);
            PG8_BAR; PG8_WAIT_L(0); PG8_MMA(1, 0, At, B0); PG8_BAR; PG8_SCHED;
            PG8_STAGE(PG8_SB(1, 1), b3 + hstep, voffB);
            PG8_WAIT_V(6); PG8_BAR; PG8_MMA(1, 1, At, B1); PG8_BAR;
        }
        PG8_STAMP();
        if constexpr (!Epi::AFTER_DRAIN) { E(acc, cur, wr, wc, fr, fq); S.done(cur); }
        PG8_STAMP();
        if (!has_next) break;
#pragma unroll
        for (int a = 0; a < 2; ++a)
#pragma unroll
            for (int b = 0; b < 2; ++b)
#pragma unroll
                for (int m = 0; m < 4; ++m)
#pragma unroll
                    for (int n = 0; n < 2; ++n) acc[a][b][m][n] = (f32x4){0.f, 0.f, 0.f, 0.f};
        cur = nxt; cA = nA; cB = nB; ++ui;
    }
    PG8_WAIT_V(0);
    if (wr == 0) PG8_BAR;
    PG8_BAR;
    if constexpr (Epi::AFTER_DRAIN) { E.fused(acc, cur, wr, wc, fr, fq, lds, wid, lane); S.done(cur); }
    PG8_STAMP();
    if (STAMP && wid == 0) { stamps[lane] = lane < nts ? (((unsigned long long)(unsigned)ts_hi << 32) | (unsigned)ts_lo) : 0ull;
        if (lane == 62) stamps[62] = rt_entry; if (lane == 63) stamps[63] = (unsigned long long)wall_clock64(); }
#undef PG8_STAMP
#undef PG8_SA
#undef PG8_SB
#undef PG8_STAGE
#undef PG8_LDA
#undef PG8_LDB
#undef PG8_MMA
#undef PG8_WAIT_V
#undef PG8_WAIT_L
#undef PG8_BAR
#undef PG8_SCHED
}
}

#define LAS __attribute__((address_space(3)))
typedef unsigned short bf16_t;
typedef short bf16x8 __attribute__((ext_vector_type(8)));
typedef float f32x4 __attribute__((ext_vector_type(4)));
typedef unsigned u32x4 __attribute__((ext_vector_type(4)));
typedef unsigned u32x2 __attribute__((ext_vector_type(2)));

constexpr int MROWS = 66048, MP = 65536, DM = 1024, DFF = 2816, NIN = 2816, NHEAD = 12;
constexpr float ALPHA_F = 1.4142135623730951f;
constexpr int LDS_BYTES = 131072;
constexpr int NTHREADS = 512;
constexpr size_t WT_FFN1IN = 0, WT_FFN1OUT = 5767168, WT_WIN = 8650752, WT_POOL = 11534336, WT_WOUT = 11599872, WT_FFN2IN = 12648448, WT_FFN2OUT = 18415616,
                 WT_GATE = 21299200, WT_PLE = 22347776, WT_LAYER = 22609920;
constexpr size_t OFF_WT = 0, OFF_R = 90439680, OFF_XB = 360972288, OFF_HZ = 496238592, OFF_PB = 868220928, OFF_PP = 935854080, WS_END = 1071120384;
constexpr size_t O_YP = 0, O_YS = 67108864, O_PP = 67633152, O_SP = 67756032, O_WP = 67837952, O_PS = 69410816, O_SS = 69533696, O_WS = 69615616;

struct Params { const float* in[35]; float* out; unsigned char* ws; };

__device__ __forceinline__ float bf_lo(unsigned w) { return __uint_as_float(w << 16); }
__device__ __forceinline__ float bf_hi(unsigned w) { return __uint_as_float(w & 0xffff0000u); }
__device__ __forceinline__ unsigned short f2bf(float f) { return (unsigned short)(pg8::cvt_pk_bf16(f, 0.f) & 0xffffu); }
__device__ __forceinline__ float wave_sum(float v) {
#pragma unroll
    for (int o = 32; o >= 1; o >>= 1) v += __shfl_xor(v, o);
    return v;
}
__device__ __forceinline__ const Params& fresh_params() { auto k = __builtin_amdgcn_kernarg_segment_ptr(); asm volatile("" : "+s"(k)); return *(const Params*)k; }
__device__ __forceinline__ int fresh_tid() { int t = threadIdx.x; asm volatile("" : "+v"(t)); return t; }
template <int CTRL> __device__ __forceinline__ float dpp_mov(float v) { return __builtin_bit_cast(float, __builtin_amdgcn_update_dpp(0, __builtin_bit_cast(int, v), CTRL, 0xF, 0xF, true)); }
__device__ __forceinline__ float allreduce8(float v) { v += dpp_mov<0xB1>(v); v += dpp_mov<0x4E>(v); v += dpp_mov<0x141>(v); return v; }
__device__ __forceinline__ float fsig(float x) { return __builtin_amdgcn_rcpf(1.0f + __builtin_amdgcn_exp2f(-1.4426950408889634f * x)); }
__device__ __forceinline__ float ftanh(float x) { return 1.0f - 2.0f * __builtin_amdgcn_rcpf(1.0f + __builtin_amdgcn_exp2f(2.8853900817779268f * x)); }

__device__ void convert_weight(const float* src, int K, int Nsrc, int Nd, int mode, bf16_t* dst, LAS float* tile) {
    const int tid = fresh_tid(), ntn = Nd / 64, ntk = K / 64;
    for (int t = blockIdx.x; t < ntn * ntk; t += gridDim.x) {
        const int tn = t % ntn, tk = t / ntn, n0 = tn * 64, k0 = tk * 64;
        int c0 = n0;
        if (mode == 1) { const int pn = n0 >> 8, w = n0 & 255; c0 = (w < 128) ? (128 * pn + w) : (DFF + 128 * pn + (w - 128)); }
#pragma unroll
        for (int i = 0; i < 2; ++i) { const int kk = (tid >> 4) + 32 * i, c4 = tid & 15;
            const f32x4 v = *(const f32x4*)(src + (size_t)(k0 + kk) * Nsrc + c0 + 4 * c4);
            tile[kk * 65 + 4 * c4 + 0] = v[0]; tile[kk * 65 + 4 * c4 + 1] = v[1]; tile[kk * 65 + 4 * c4 + 2] = v[2]; tile[kk * 65 + 4 * c4 + 3] = v[3]; }
        __syncthreads();
        { const int n = tid >> 3, k8 = tid & 7; float f[8];
#pragma unroll
            for (int j = 0; j < 8; ++j) f[j] = tile[(k8 * 8 + j) * 65 + n];
            u32x4 w; w.x = pg8::cvt_pk_bf16(f[0], f[1]); w.y = pg8::cvt_pk_bf16(f[2], f[3]); w.z = pg8::cvt_pk_bf16(f[4], f[5]); w.w = pg8::cvt_pk_bf16(f[6], f[7]);
            *(u32x4*)(dst + (size_t)(n0 + n) * K + k0 + k8 * 8) = w; }
        __syncthreads();
    }
}
__device__ void prologue(LAS unsigned char* lds) {
    const Params& p = fresh_params();
    LAS float* tile = (LAS float*)lds;
    bf16_t* WT = (bf16_t*)(p.ws + OFF_WT);
    for (int l = 0; l < 2; ++l) {
        bf16_t* W = WT + (size_t)l * WT_LAYER;
        convert_weight(p.in[13] + (size_t)l * DM * 2 * DFF, DM, 2 * DFF, 2 * DFF, 1, W + WT_FFN1IN, tile);
        convert_weight(p.in[14] + (size_t)l * DFF * DM, DFF, DM, DM, 0, W + WT_FFN1OUT, tile);
        convert_weight(p.in[17] + (size_t)l * DM * NIN, DM, NIN, NIN, 0, W + WT_WIN, tile);
        convert_weight(p.in[31] + (size_t)l * DM * DM, DM, DM, DM, 0, W + WT_WOUT, tile);
        convert_weight(p.in[15] + (size_t)l * DM * 2 * DFF, DM, 2 * DFF, 2 * DFF, 1, W + WT_FFN2IN, tile);
        convert_weight(p.in[16] + (size_t)l * DFF * DM, DFF, DM, DM, 0, W + WT_FFN2OUT, tile);
        convert_weight(p.in[32] + (size_t)l * DM * DM, DM, DM, DM, 0, W + WT_GATE, tile);
        convert_weight(p.in[34] + (size_t)l * 256 * DM, 256, DM, DM, 0, W + WT_PLE, tile);
        const float* pw = p.in[19] + (size_t)l * 4 * 64 * 64;
        for (int i = blockIdx.x * NTHREADS + fresh_tid(); i < 256 * 256; i += gridDim.x * NTHREADS) {
            const int n = i >> 8, k = i & 255, g = n >> 6, d = n & 63, g2 = k >> 6, c = k & 63;
            W[WT_POOL + i] = (g == g2) ? f2bf(pw[(g * 64 + c) * 64 + d]) : (bf16_t)0;
        }
    }
    bf16_t* XB = (bf16_t*)(p.ws + OFF_XB);
    const size_t gt = (size_t)blockIdx.x * NTHREADS + fresh_tid(), gs = (size_t)gridDim.x * NTHREADS;
    for (size_t i = gt; i < (size_t)MROWS * DM / 8; i += gs) {
        const size_t e = i * 8; const float* s = (e < (size_t)MP * DM) ? p.in[0] + e : p.in[1] + (e - (size_t)MP * DM);
        const f32x4 a = *(const f32x4*)s, b = *(const f32x4*)(s + 4);
        u32x4 w; w.x = pg8::cvt_pk_bf16(a[0], a[1]); w.y = pg8::cvt_pk_bf16(a[2], a[3]); w.z = pg8::cvt_pk_bf16(b[0], b[1]); w.w = pg8::cvt_pk_bf16(b[2], b[3]);
        *(u32x4*)(XB + e) = w;
    }
    bf16_t* PB = (bf16_t*)(p.ws + OFF_PB);
    for (size_t i = gt; i < (size_t)2 * MROWS * 256 / 8; i += gs) {
        const size_t e = i * 8; const int l = (int)(e / ((size_t)MROWS * 256)); const size_t r = e - (size_t)l * MROWS * 256;
        const float* s = (r < (size_t)MP * 256) ? p.in[2] + (size_t)l * MP * 256 + r : p.in[3] + (size_t)l * 512 * 256 + (r - (size_t)MP * 256);
        const f32x4 a = *(const f32x4*)s, b = *(const f32x4*)(s + 4);
        u32x4 w; w.x = pg8::cvt_pk_bf16(a[0], a[1]); w.y = pg8::cvt_pk_bf16(a[2], a[3]); w.z = pg8::cvt_pk_bf16(b[0], b[1]); w.w = pg8::cvt_pk_bf16(b[2], b[3]);
        *(u32x4*)(PB + e) = w;
    }
}

__device__ void ln_phase(float* R, const float* g, const float* b, bf16_t* xb, float* outp, float* outs) {
    const int tid = fresh_tid(), lane = tid & 63, wave = tid >> 6;
    f32x4 gv[4], bv[4];
#pragma unroll
    for (int i = 0; i < 4; ++i) { gv[i] = *(const f32x4*)(g + i * 256 + lane * 4); bv[i] = *(const f32x4*)(b + i * 256 + lane * 4); }
    for (int row = blockIdx.x * 8 + wave; row < MROWS; row += gridDim.x * 8) {
        float* rp = R + (size_t)row * DM;
        f32x4 v[4]; float s = 0.f;
#pragma unroll
        for (int i = 0; i < 4; ++i) { v[i] = *(const f32x4*)(rp + i * 256 + lane * 4); s += (v[i][0] + v[i][1]) + (v[i][2] + v[i][3]); }
        const float mean = wave_sum(s) * (1.0f / 1024.0f);
        float q = 0.f;
#pragma unroll
        for (int i = 0; i < 4; ++i) { v[i] = v[i] - mean; q += (v[i][0] * v[i][0] + v[i][1] * v[i][1]) + (v[i][2] * v[i][2] + v[i][3] * v[i][3]); }
        const float rstd = 1.0f / sqrtf(wave_sum(q) * (1.0f / 1024.0f) + 1e-5f);
        float* op = outp ? ((row < MP) ? outp + (size_t)row * DM : outs + (size_t)(row - MP) * DM) : rp;
#pragma unroll
        for (int i = 0; i < 4; ++i) { const f32x4 y = v[i] * rstd * gv[i] + bv[i];
            *(f32x4*)(op + i * 256 + lane * 4) = y;
            if (xb) { u32x2 w; w.x = pg8::cvt_pk_bf16(y[0], y[1]); w.y = pg8::cvt_pk_bf16(y[2], y[3]); *(u32x2*)(xb + (size_t)row * DM + i * 256 + lane * 4) = w; } }
    }
}

__device__ void mixprep_phase(int l, const bf16_t* Z, bf16_t* pooled) {
    const Params& p = fresh_params();
    const size_t gt = (size_t)blockIdx.x * NTHREADS + fresh_tid(), gs = (size_t)gridDim.x * NTHREADS;
    const float* hist_all = p.in[4] + (size_t)l * 16 * 15 * 256;
    for (size_t task = gt; task < (size_t)MROWS * 32; task += gs) {
        const int row = (int)(task >> 5), c8 = (int)(task & 31), col = c8 * 8, w = 2 << (c8 >> 3);
        const bool samp = row >= MP; const int b = samp ? ((row - MP) >> 5) : (row >> 12), t = samp ? ((row - MP) & 31) : (row & 4095);
        float acc[8], u0[8];
#pragma unroll
        for (int j = 0; j < 8; ++j) acc[j] = 0.f;
        for (int d = 0; d < w; ++d) {
            const int tt = t - d;
            if (tt >= 0) { const u32x4 q = *(const u32x4*)(Z + (size_t)(row - d) * NIN + col);
                const float f0 = bf_lo(q.x), f1 = bf_hi(q.x), f2 = bf_lo(q.y), f3 = bf_hi(q.y), f4 = bf_lo(q.z), f5 = bf_hi(q.z), f6 = bf_lo(q.w), f7 = bf_hi(q.w);
                if (d == 0) { u0[0] = f0; u0[1] = f1; u0[2] = f2; u0[3] = f3; u0[4] = f4; u0[5] = f5; u0[6] = f6; u0[7] = f7; }
                acc[0] += f0; acc[1] += f1; acc[2] += f2; acc[3] += f3; acc[4] += f4; acc[5] += f5; acc[6] += f6; acc[7] += f7; }
            else if (samp) { const float* hp = hist_all + ((size_t)b * 15 + (15 + tt)) * 256 + col; const f32x4 a = *(const f32x4*)hp, c = *(const f32x4*)(hp + 4);
                acc[0] += a[0]; acc[1] += a[1]; acc[2] += a[2]; acc[3] += a[3]; acc[4] += c[0]; acc[5] += c[1]; acc[6] += c[2]; acc[7] += c[3]; }
        }
        const float inv = 1.0f / (float)(samp ? w : ((t + 1 < w) ? (t + 1) : w));
        u32x4 o; o.x = pg8::cvt_pk_bf16(acc[0] * inv - u0[0], acc[1] * inv - u0[1]); o.y = pg8::cvt_pk_bf16(acc[2] * inv - u0[2], acc[3] * inv - u0[3]);
        o.z = pg8::cvt_pk_bf16(acc[4] * inv - u0[4], acc[5] * inv - u0[5]); o.w = pg8::cvt_pk_bf16(acc[6] * inv - u0[6], acc[7] * inv - u0[7]);
        *(u32x4*)(pooled + (size_t)row * 256 + col) = o;
        const int T = samp ? 32 : 4096;
        if (t >= T - 15) { float* op = p.out + (samp ? O_PS : O_PP) + (((size_t)l * 16 + b) * 15 + (t - (T - 15))) * 256 + col;
            *(f32x4*)op = (f32x4){u0[0], u0[1], u0[2], u0[3]}; *(f32x4*)(op + 4) = (f32x4){u0[4], u0[5], u0[6], u0[7]}; }
    }
    for (size_t i = gt; i < (size_t)32 * 2560; i += gs) {
        const int s = (int)(i / 2560), c = (int)(i % 2560); const bool samp = s >= 16; const int b = s & 15;
        const int row = samp ? (MP + b * 32 + 31) : (b * 4096 + 4095);
        p.out[(samp ? O_SS : O_SP) + ((size_t)l * 16 + b) * 2560 + c] = __uint_as_float((unsigned)Z[(size_t)row * NIN + 256 + c] << 16);
    }
}

constexpr int SC_R = 0, SC_W = 8192, SC_K = 16384, SC_V = 24576, SC_A = 32768, SC_B = 40960, SC_G = 49152, SC_Y = 57344, SC_AL = 65536,
              SC_XW = 73728, SC_XL = 77824, SC_XG = 81920, SC_W2 = 90112, SC_A2 = 98304, SC_G2 = 106496, SC_BON = 122880;
__device__ void scan_phase(int l, const bf16_t* Z, bf16_t* mixin, LAS unsigned char* lds) {
    const Params& p = fresh_params();
    const int tid = fresh_tid(), lane = tid & 63, wave = tid >> 6;
    LAS float* opR = (LAS float*)(lds + SC_R); LAS float* opW = (LAS float*)(lds + SC_W); LAS float* opK = (LAS float*)(lds + SC_K); LAS float* opV = (LAS float*)(lds + SC_V);
    LAS float* opA = (LAS float*)(lds + SC_A); LAS float* opB = (LAS float*)(lds + SC_B); LAS float* gV = (LAS float*)(lds + SC_G); LAS float* yB = (LAS float*)(lds + SC_Y);
    LAS float* aL = (LAS float*)(lds + SC_AL); LAS float* bon = (LAS float*)(lds + SC_BON);
    LAS bf16_t* xW = (LAS bf16_t*)(lds + SC_XW); LAS bf16_t* xL = (LAS bf16_t*)(lds + SC_XL); LAS bf16_t* xG = (LAS bf16_t*)(lds + SC_XG);
    LAS bf16_t* w2t = (LAS bf16_t*)(lds + SC_W2); LAS bf16_t* a2t = (LAS bf16_t*)(lds + SC_A2); LAS bf16_t* g2t = (LAS bf16_t*)(lds + SC_G2);
    const float* mu = p.in[18] + (size_t)l * 2560;
    const int rl = lane >> 3, kg = lane & 7, srow = wave * 8 + rl;
    const int fr = lane & 15, fq = lane >> 4, tt = wave >> 2, nt = wave & 3;
    for (int unit = blockIdx.x; unit < 384; unit += gridDim.x) {
        const bool samp = unit >= 192; const int uu = samp ? unit - 192 : unit, b = uu / 12, h = uu % 12;
        const int T = samp ? 32 : 4096, row0 = samp ? (MP + b * 32) : (b * 4096);
        __syncthreads();
        for (int i = tid; i < 64 * 64; i += NTHREADS) { const int k = i >> 6, n = i & 63;
            w2t[n * 64 + k] = f2bf(p.in[22][((size_t)l * 64 + k) * 768 + h * 64 + n]);
            a2t[n * 64 + k] = f2bf(p.in[24][((size_t)l * 64 + k) * 768 + h * 64 + n]); }
        for (int i = tid; i < 128 * 64; i += NTHREADS) { const int k = i >> 6, n = i & 63;
            g2t[n * 128 + k] = f2bf(p.in[25][((size_t)l * 128 + k) * 768 + h * 64 + n]); }
        const int hc = h * 64 + lane;
        const float c_kk = p.in[26][l * 768 + hc], c_ka = p.in[27][l * 768 + hc], c_rk = p.in[28][l * 768 + hc], c_lg = p.in[29][l * 768 + hc], c_lb = p.in[30][l * 768 + hc];
        const float c_w0 = p.in[21][l * 768 + h * 64 + nt * 16 + fr], c_a0 = p.in[23][l * 768 + h * 64 + nt * 16 + fr];
        const int cc = lane;
        const int zc = (cc < 24) ? ((cc >> 3) * 768 + h * 64 + (cc & 7) * 8) : (2304 + ((cc < 56 ? cc : 55) - 24) * 8);
        const f32x4 m0 = *(const f32x4*)(mu + zc), m1 = *(const f32x4*)(mu + zc + 4);
        float s0, s1, s2, s3, s4, s5, s6, s7;
        if (samp) { const float* sp = p.in[6] + ((((size_t)l * 16 + b) * 12 + h) * 64 + srow) * 64 + 8 * kg; const f32x4 x = *(const f32x4*)sp, y = *(const f32x4*)(sp + 4);
            s0 = x[0]; s1 = x[1]; s2 = x[2]; s3 = x[3]; s4 = y[0]; s5 = y[1]; s6 = y[2]; s7 = y[3]; }
        else { s0 = s1 = s2 = s3 = s4 = s5 = s6 = s7 = 0.f; }
        for (int t0 = 0; t0 < T; t0 += 32) {
#pragma unroll 1
            for (int tl = wave; tl < 32 && cc < 56; tl += 8) {
                const size_t grow = (size_t)row0 + t0 + tl;
                const u32x4 q = *(const u32x4*)(Z + grow * NIN + 256 + zc);
                float cur[8] = {bf_lo(q.x), bf_hi(q.x), bf_lo(q.y), bf_hi(q.y), bf_lo(q.z), bf_hi(q.z), bf_lo(q.w), bf_hi(q.w)};
                float prv[8];
                if (t0 + tl > 0) { const u32x4 r = *(const u32x4*)(Z + (grow - 1) * NIN + 256 + zc);
                    prv[0] = bf_lo(r.x); prv[1] = bf_hi(r.x); prv[2] = bf_lo(r.y); prv[3] = bf_hi(r.y); prv[4] = bf_lo(r.z); prv[5] = bf_hi(r.z); prv[6] = bf_lo(r.w); prv[7] = bf_hi(r.w); }
                else if (samp) { const float* sp = p.in[5] + ((size_t)l * 16 + b) * 2560 + zc; const f32x4 x = *(const f32x4*)sp, y = *(const f32x4*)(sp + 4);
                    prv[0] = x[0]; prv[1] = x[1]; prv[2] = x[2]; prv[3] = x[3]; prv[4] = y[0]; prv[5] = y[1]; prv[6] = y[2]; prv[7] = y[3]; }
                else {
#pragma unroll
                    for (int j = 0; j < 8; ++j) prv[j] = 0.f; }
                float zs[8];
#pragma unroll
                for (int j = 0; j < 8; ++j) zs[j] = cur[j] + (prv[j] - cur[j]) * (j < 4 ? m0[j] : m1[j - 4]);
                if (cc < 24) { LAS float* dst = (cc < 8 ? opR : (cc < 16 ? opK : opV)) + tl * 64 + (cc & 7) * 8;
                    *(LAS f32x4*)dst = (f32x4){zs[0], zs[1], zs[2], zs[3]}; *(LAS f32x4*)(dst + 4) = (f32x4){zs[4], zs[5], zs[6], zs[7]}; }
                else {
                    LAS bf16_t* dst;
                    if (cc < 32) { dst = xW + tl * 64 + (cc - 24) * 8;
#pragma unroll
                        for (int j = 0; j < 8; ++j) zs[j] = ftanh(zs[j]); }
                    else if (cc < 40) { dst = xL + tl * 64 + (cc - 32) * 8; }
                    else { dst = xG + tl * 128 + (cc - 40) * 8;
#pragma unroll
                        for (int j = 0; j < 8; ++j) zs[j] = fsig(zs[j]); }
                    u32x4 w; w.x = pg8::cvt_pk_bf16(zs[0], zs[1]); w.y = pg8::cvt_pk_bf16(zs[2], zs[3]); w.z = pg8::cvt_pk_bf16(zs[4], zs[5]); w.w = pg8::cvt_pk_bf16(zs[6], zs[7]);
                    *(LAS u32x4*)dst = w; }
            }
            __syncthreads();
            {
                f32x4 dw = {0.f, 0.f, 0.f, 0.f}, da = dw, dg = dw;
#pragma unroll
                for (int ks = 0; ks < 2; ++ks) {
                    const bf16x8 xa = *(const LAS bf16x8*)(xW + (tt * 16 + fr) * 64 + ks * 32 + fq * 8), wb = *(const LAS bf16x8*)(w2t + (nt * 16 + fr) * 64 + ks * 32 + fq * 8);
                    dw = __builtin_amdgcn_mfma_f32_16x16x32_bf16(xa, wb, dw, 0, 0, 0);
                    const bf16x8 xb2 = *(const LAS bf16x8*)(xL + (tt * 16 + fr) * 64 + ks * 32 + fq * 8), ab = *(const LAS bf16x8*)(a2t + (nt * 16 + fr) * 64 + ks * 32 + fq * 8);
                    da = __builtin_amdgcn_mfma_f32_16x16x32_bf16(xb2, ab, da, 0, 0, 0);
                }
#pragma unroll
                for (int ks = 0; ks < 4; ++ks) {
                    const bf16x8 xg = *(const LAS bf16x8*)(xG + (tt * 16 + fr) * 128 + ks * 32 + fq * 8), gb = *(const LAS bf16x8*)(g2t + (nt * 16 + fr) * 128 + ks * 32 + fq * 8);
                    dg = __builtin_amdgcn_mfma_f32_16x16x32_bf16(xg, gb, dg, 0, 0, 0);
                }
#pragma unroll
                for (int j = 0; j < 4; ++j) { const int o = (tt * 16 + 4 * fq + j) * 64 + nt * 16 + fr;
                    opW[o] = __builtin_amdgcn_exp2f(-0.8750402888f * fsig(c_w0 + dw[j]));
                    aL[o] = fsig(c_a0 + da[j]); gV[o] = dg[j]; }
            }
            __syncthreads();
#pragma unroll
            for (int i = 0; i < 4; ++i) { const int o = (wave * 4 + i) * 64 + lane;
                const float kr = opK[o], a = aL[o], r = opR[o];
                float kk = kr * c_kk; const float nn = wave_sum(kk * kk); kk = kk / fmaxf(sqrtf(nn), 1e-12f);
                const float kp = kr * (1.0f + (a - 1.0f) * c_ka);
                opK[o] = kp; opA[o] = -kk; opB[o] = kk * a;
                const float bs = wave_sum(r * kp * c_rk); if (lane == 0) bon[wave * 4 + i] = bs; }
            __syncthreads();
            {
#define SC_LOAD(P, T) do { const int o_ = (T) * 64 + 8 * kg; P##a0 = *(const LAS f32x4*)(opA + o_); P##a1 = *(const LAS f32x4*)(opA + o_ + 4); P##w0 = *(const LAS f32x4*)(opW + o_); P##w1 = *(const LAS f32x4*)(opW + o_ + 4); \
    P##b0 = *(const LAS f32x4*)(opB + o_); P##b1 = *(const LAS f32x4*)(opB + o_ + 4); P##k0 = *(const LAS f32x4*)(opK + o_); P##k1 = *(const LAS f32x4*)(opK + o_ + 4); \
    P##r0 = *(const LAS f32x4*)(opR + o_); P##r1 = *(const LAS f32x4*)(opR + o_ + 4); P##vv = opV[(T) * 64 + srow]; } while (0)
                f32x4 c_a0, c_a1, c_w0, c_w1, c_b0, c_b1, c_k0, c_k1, c_r0, c_r1; float c_vv;
                f32x4 n_a0, n_a1, n_w0, n_w1, n_b0, n_b1, n_k0, n_k1, n_r0, n_r1; float n_vv;
                SC_LOAD(c_, 0);
                float yr = 0.f;
#pragma unroll 2
                for (int t = 0; t < 32; ++t) {
                    const int tn = (t + 1) & 31;
                    SC_LOAD(n_, tn);
                    float sa = ((s0 * c_a0[0] + s1 * c_a0[1]) + (s2 * c_a0[2] + s3 * c_a0[3])) + ((s4 * c_a1[0] + s5 * c_a1[1]) + (s6 * c_a1[2] + s7 * c_a1[3]));
                    sa = allreduce8(sa);
                    s0 = s0 * c_w0[0] + (sa * c_b0[0] + c_vv * c_k0[0]); s1 = s1 * c_w0[1] + (sa * c_b0[1] + c_vv * c_k0[1]); s2 = s2 * c_w0[2] + (sa * c_b0[2] + c_vv * c_k0[2]); s3 = s3 * c_w0[3] + (sa * c_b0[3] + c_vv * c_k0[3]);
                    s4 = s4 * c_w1[0] + (sa * c_b1[0] + c_vv * c_k1[0]); s5 = s5 * c_w1[1] + (sa * c_b1[1] + c_vv * c_k1[1]); s6 = s6 * c_w1[2] + (sa * c_b1[2] + c_vv * c_k1[2]); s7 = s7 * c_w1[3] + (sa * c_b1[3] + c_vv * c_k1[3]);
                    float y = ((s0 * c_r0[0] + s1 * c_r0[1]) + (s2 * c_r0[2] + s3 * c_r0[3])) + ((s4 * c_r1[0] + s5 * c_r1[1]) + (s6 * c_r1[2] + s7 * c_r1[3]));
                    y = allreduce8(y);
                    if ((t & 7) == kg) yr = y;
                    if ((t & 7) == 7) yB[((t & 24) + kg) * 64 + srow] = yr;
                    c_a0 = n_a0; c_a1 = n_a1; c_w0 = n_w0; c_w1 = n_w1; c_b0 = n_b0; c_b1 = n_b1; c_k0 = n_k0; c_k1 = n_k1; c_r0 = n_r0; c_r1 = n_r1; c_vv = n_vv;
                }
#undef SC_LOAD
            }
            __syncthreads();
#pragma unroll
            for (int i = 0; i < 4; ++i) { const int tl = wave * 4 + i, o = tl * 64 + lane;
                const float y = yB[o]; const float mean = wave_sum(y) * (1.0f / 64.0f); const float d = y - mean; const float var = wave_sum(d * d) * (1.0f / 64.0f);
                const float yn = d * (1.0f / sqrtf(var + 64e-5f)) * c_lg + c_lb;
                const float ov = (yn + bon[tl] * opV[o]) * gV[o];
                mixin[((size_t)row0 + t0 + tl) * DM + 256 + hc] = f2bf(ov); }
            __syncthreads();
        }
        { float* sp = p.out + (samp ? O_WS : O_WP) + ((((size_t)l * 16 + b) * 12 + h) * 64 + srow) * 64 + 8 * kg;
            *(f32x4*)sp = (f32x4){s0, s1, s2, s3}; *(f32x4*)(sp + 4) = (f32x4){s4, s5, s6, s7}; }
    }
    __syncthreads();
}

template <class Epi> __device__ __forceinline__ void run_gemm(LAS unsigned char* lds, const bf16_t* A, const bf16_t* Bt, int N, int K, const Epi& E, int rot) {
    asm volatile("" : "+s"(K), "+s"(N));
    pg8::Gemm g{A, Bt, MROWS, N, K}; pg8::StaticOrder S; S.init(MROWS, N, (int)gridDim.x, (int)((blockIdx.x + rot) % gridDim.x));
    pg8::gemm_phase<Epi, pg8::StaticOrder, false>((PG8_LAS unsigned char*)lds, g, S, E, nullptr);
}

__global__ void __launch_bounds__(NTHREADS, 2) mega_fwd(Params p_unused) {
    extern __shared__ __attribute__((aligned(16))) unsigned char lds_raw[];
    LAS unsigned char* lds = (LAS unsigned char*)lds_raw;
    cg::grid_group grid = cg::this_grid();
    unsigned char* ws = fresh_params().ws;
    bf16_t* WT = (bf16_t*)(ws + OFF_WT); float* R = (float*)(ws + OFF_R); bf16_t* XB = (bf16_t*)(ws + OFF_XB); bf16_t* HZ = (bf16_t*)(ws + OFF_HZ);
    bf16_t* PB = (bf16_t*)(ws + OFF_PB); bf16_t* PPb = (bf16_t*)(ws + OFF_PP); bf16_t* POOLED = PPb;

    prologue(lds);
    grid.sync();
    for (int l = 0; l < 2; ++l) {
        const Params& p = fresh_params();
        const bf16_t* W = WT + (size_t)l * WT_LAYER;
        { pg8::EpiSwiglu E{HZ, DFF}; run_gemm(lds, XB, W + WT_FFN1IN, 2 * DFF, DM, E, 0); }
        grid.sync();
        { pg8::EpiResid E{l == 0 ? p.in[0] : R, l == 0 ? p.in[1] - (size_t)MP * DM : R, MP, R, nullptr, DM, ALPHA_F, 0.5f}; run_gemm(lds, HZ, W + WT_FFN1OUT, DM, DFF, E, 0); }
        grid.sync();
        ln_phase(R, p.in[7] + l * DM, p.in[8] + l * DM, XB, nullptr, nullptr);
        grid.sync();
        { pg8::EpiStoreBf16 E{HZ, NIN, nullptr}; run_gemm(lds, XB, W + WT_WIN, NIN, DM, E, 0); }
        grid.sync();
        mixprep_phase(l, HZ, POOLED);
        grid.sync();
        { pg8::EpiStoreBf16 E{XB, DM, p.in[20] + l * 256}; run_gemm(lds, POOLED, W + WT_POOL, 256, 256, E, 0); }
        scan_phase(l, HZ, XB, lds);
        grid.sync();
        { pg8::EpiResid E{R, R, MP, R, nullptr, DM, ALPHA_F, 1.0f}; run_gemm(lds, XB, W + WT_WOUT, DM, DM, E, 0); }
        grid.sync();
        ln_phase(R, p.in[9] + l * DM, p.in[10] + l * DM, XB, nullptr, nullptr);
        grid.sync();
        { pg8::EpiSwiglu E{HZ, DFF}; run_gemm(lds, XB, W + WT_FFN2IN, 2 * DFF, DM, E, 0); }
        grid.sync();
        { pg8::EpiResid E{R, R, MP, R, XB, DM, ALPHA_F, 0.5f}; run_gemm(lds, HZ, W + WT_FFN2OUT, DM, DFF, E, 0); }
        { pg8::EpiStoreBf16 E{PPb, DM, nullptr}; run_gemm(lds, PB + (size_t)l * MROWS * 256, W + WT_PLE, DM, 256, E, 128); }
        grid.sync();
        { pg8::EpiGate E{R, PPb, p.in[33] + l * DM, DM}; run_gemm(lds, XB, W + WT_GATE, DM, DM, E, 0); }
        grid.sync();
        if (l == 0) ln_phase(R, p.in[11], p.in[12], XB, nullptr, nullptr);
        else ln_phase(R, p.in[11] + DM, p.in[12] + DM, nullptr, p.out + O_YP, p.out + O_YS);
        if (l == 0) grid.sync();
    }
}

extern "C" void kernel_launch(void* const* d_in, const int* in_sizes, int n_in, void* d_out, int out_size, void* d_ws, size_t ws_size, hipStream_t stream) {
    static int grid_blocks = 0;
    if (grid_blocks == 0) {
        if (n_in != 35 || ws_size < WS_END) { fprintf(stderr, "kernel_launch: expected 35 inputs and >= %zu bytes of workspace, got %d and %zu\n", (size_t)WS_END, n_in, ws_size); grid_blocks = -1; return; }
        int dev = 0, cus = 0, per_cu = 0;
        hipGetDevice(&dev);
        hipDeviceGetAttribute(&cus, hipDeviceAttributeMultiprocessorCount, dev);
        if (hipFuncSetAttribute((const void*)mega_fwd, hipFuncAttributeMaxDynamicSharedMemorySize, LDS_BYTES) != hipSuccess) { fprintf(stderr, "kernel_launch: hipFuncSetAttribute failed\n"); (void)hipGetLastError(); }
        if (hipOccupancyMaxActiveBlocksPerMultiprocessor(&per_cu, (const void*)mega_fwd, NTHREADS, LDS_BYTES) != hipSuccess || per_cu < 1) { fprintf(stderr, "kernel_launch: occupancy query gave %d\n", per_cu); per_cu = 1; (void)hipGetLastError(); }
        grid_blocks = cus * per_cu;
    }
    if (grid_blocks < 0) return;
    Params p{};
    for (int i = 0; i < 35; ++i) p.in[i] = (const float*)d_in[i];
    p.out = (float*)d_out; p.ws = (unsigned char*)d_ws;
    void* args[] = {&p};
    hipError_t e = hipLaunchCooperativeKernel((const void*)mega_fwd, dim3(grid_blocks), dim3(NTHREADS), args, LDS_BYTES, stream);
    if (e != hipSuccess) fprintf(stderr, "cooperative launch failed: %s (grid %d)\n", hipGetErrorString(e), grid_blocks);
}
```

```cpp
#include <hip/hip_runtime.h>
#include <hip/hip_cooperative_groups.h>
#include <cstdio>
namespace cg = cooperative_groups;
namespace pg8 {
#define PG8_LAS __attribute__((address_space(3)))
typedef unsigned short bf16_t;
typedef short bf16x8 __attribute__((ext_vector_type(8)));
typedef float f32x4 __attribute__((ext_vector_type(4)));
typedef unsigned u32x4 __attribute__((ext_vector_type(4)));
constexpr int BM = 256, BK = 64, HALF = 128, HTB = HALF * BK * 2  , STAGE_BYTES = 8 * HTB, NXCD = 8, WGM = 8;

__host__ __device__ __forceinline__ int lds_byte(int r, int c) { const int st = (r >> 4) * 2 + (c >> 5), rr = r & 15, cc = c & 31, ob = rr * 64 + cc * 2; return st * 1024 + (ob ^ (((ob >> 9) & 1) << 5)); }
__host__ __device__ __forceinline__ void stage_rc(int b, int& R, int& C) { const int st = b / 1024, sb = b % 1024, swz = sb ^ (((sb >> 9) & 1) << 5); R = (st >> 1) * 16 + swz / 64; C = (st & 1) * 32 + (swz % 64) / 2; }
__host__ __device__ __forceinline__ int perm32(int rho) { const int n = rho >> 4, i = rho & 15; return 8 * (i >> 2) + 4 * n + (i & 3); }

struct Unit { int pm, pn; };
struct Gemm { const bf16_t* A; const bf16_t* Bt; int M, N, K; };

struct StaticOrder {
    int nM, nN, nwg, G, c;
    __host__ __device__ void init(int M, int N, int G_, int c_) { nM = M / BM; nN = N / BM; nwg = nM * nN; G = G_; c = c_; }
    __host__ __device__ bool next(int i, Unit& u) const {
        const long L = (long)i * G + c; if (L >= nwg) return false;
        int wgid = (int)L; { const int q = nwg / NXCD, r = nwg % NXCD, xcd = wgid % NXCD, off = wgid / NXCD; wgid = (xcd < r ? xcd * (q + 1) : r * (q + 1) + (xcd - r) * q) + off; }
        const int nig = WGM * nN, gid = wgid / nig, fm = gid * WGM, gsz = (nM - fm) < WGM ? (nM - fm) : WGM;
        u.pm = fm + ((wgid % nig) % gsz); u.pn = (wgid % nig) / gsz; return true;
    }
    __device__ __forceinline__ void a_ready(const Unit&) const {}
    __device__ __forceinline__ void done(const Unit&) const {}
};
struct RangeOrder : StaticOrder { int i0, i1;
    __host__ __device__ bool next(int i, Unit& u) const { return (i + i0 < i1) && StaticOrder::next(i + i0, u); } };
__device__ __forceinline__ unsigned cvt_pk_bf16(float lo, float hi) { typedef float f2_ __attribute__((ext_vector_type(2))); typedef __bf16 b2_ __attribute__((ext_vector_type(2))); const f2_ v = {lo, hi}; return __builtin_bit_cast(unsigned, __builtin_convertvector(v, b2_)); }
typedef float f32x2 __attribute__((ext_vector_type(2)));
typedef unsigned u32x2 __attribute__((ext_vector_type(2)));
__device__ __forceinline__ float fast_sigmoid(float x) { return __builtin_amdgcn_rcpf(1.0f + __builtin_amdgcn_exp2f(-1.4426950408889634f * x)); }

struct EpiSwiglu {
    static constexpr bool PERM = true, AFTER_DRAIN = false;
    bf16_t* H; int ldh;
    __device__ __forceinline__ void operator()(const f32x4 (&acc)[2][2][4][2], const Unit& u, int wr, int wc, int fr, int fq) const {
        const int row0 = u.pm * BM + wr * 64 + fr, col0 = u.pn * HALF + wc * 32 + 8 * fq;
#pragma unroll
        for (int ai = 0; ai < 2; ++ai)
#pragma unroll
            for (int m = 0; m < 4; ++m) {
                bf16_t* rowp = H + (size_t)(row0 + ai * HALF + m * 16) * ldh + col0;
                float h[8];
#pragma unroll
                for (int n = 0; n < 2; ++n)
#pragma unroll
                    for (int j = 0; j < 4; ++j) { const float g = acc[ai][0][m][n][j], up = acc[ai][1][m][n][j]; h[n * 4 + j] = g * fast_sigmoid(g) * up; }
                u32x4 w; w.x = cvt_pk_bf16(h[0], h[1]); w.y = cvt_pk_bf16(h[2], h[3]); w.z = cvt_pk_bf16(h[4], h[5]); w.w = cvt_pk_bf16(h[6], h[7]);
                *(u32x4*)rowp = w;
            }
    }
};
struct EpiStoreBf16 {
    static constexpr bool PERM = true, AFTER_DRAIN = false;
    bf16_t* O; int ldc; const float* cscale;
    __device__ __forceinline__ void operator()(const f32x4 (&acc)[2][2][4][2], const Unit& u, int wr, int wc, int fr, int fq) const {
        const int row0 = u.pm * BM + wr * 64 + fr, col0 = u.pn * BM + wc * 32 + 8 * fq;
        f32x4 sc[2][2];
#pragma unroll
        for (int bj = 0; bj < 2; ++bj)
#pragma unroll
            for (int n = 0; n < 2; ++n) sc[bj][n] = cscale ? *(const f32x4*)(cscale + col0 + bj * HALF + 4 * n) : (f32x4){1.f, 1.f, 1.f, 1.f};
#pragma unroll
        for (int ai = 0; ai < 2; ++ai)
#pragma unroll
            for (int m = 0; m < 4; ++m) { bf16_t* rowp = O + (size_t)(row0 + ai * HALF + m * 16) * ldc + col0;
#pragma unroll
                for (int bj = 0; bj < 2; ++bj) { const f32x4 v0 = acc[ai][bj][m][0] * sc[bj][0], v1 = acc[ai][bj][m][1] * sc[bj][1];
                    u32x4 w; w.x = cvt_pk_bf16(v0[0], v0[1]); w.y = cvt_pk_bf16(v0[2], v0[3]); w.z = cvt_pk_bf16(v1[0], v1[1]); w.w = cvt_pk_bf16(v1[2], v1[3]);
                    *(u32x4*)(rowp + bj * HALF) = w; } }
    }
};
struct EpiResidIn {
    static constexpr bool PERM = false, AFTER_DRAIN = false;
    const float* srcA; const float* srcB; int split_row; float* out; float sa, sb;
    __device__ __forceinline__ void operator()(const f32x4 (&acc)[2][2][4][2], const Unit& u, int wr, int wc, int fr, int fq) const {
        constexpr int ldc = 1024;
        const int row0 = u.pm * BM + wr * 64 + fr, col0 = u.pn * BM + wc * 32 + 4 * fq;
        const float* src = (u.pm * BM >= split_row) ? srcB : srcA;
#pragma unroll
        for (int ai = 0; ai < 2; ++ai)
#pragma unroll
            for (int m = 0; m < 4; ++m) { const size_t off = (size_t)(row0 + ai * HALF + m * 16) * ldc + col0;
#pragma unroll
                for (int bj = 0; bj < 2; ++bj)
#pragma unroll
                    for (int n = 0; n < 2; ++n) { const f32x4 s = *(const f32x4*)(src + off + bj * HALF + n * 16); *(f32x4*)(out + off + bj * HALF + n * 16) = s * sa + acc[ai][bj][m][n] * sb; }
                asm volatile("" ::: "memory"); }
    }
};
template <bool OB, bool SBHALF> struct EpiResidLN {
    static constexpr bool PERM = false, AFTER_DRAIN = false;
    float* out; bf16_t* ob; int stats_off, gb_off;
    __device__ __forceinline__ void operator()(const f32x4 (&acc)[2][2][4][2], const Unit& u, int wr, int wc, int fr, int fq) const {
        constexpr int ldc = 1024;
        const int row0 = u.pm * BM + wr * 64 + fr, col0 = u.pn * BM + wc * 32 + 4 * fq;
        float* const out = this->out; bf16_t* const ob = this->ob; const float sa = 1.4142135623730951f, sb = SBHALF ? 0.5f : 1.0f;
        const float* const stats = (const float*)((const char*)out + stats_off); const float* const gb = (const float*)((const char*)out + gb_off);
#pragma unroll
        for (int bj = 0; bj < 2; ++bj)
#pragma unroll
            for (int n = 0; n < 2; ++n) {
                const int cc = col0 + bj * HALF + n * 16;
                const f32x4 gv = *(const f32x4*)(gb + cc), bv = *(const f32x4*)(gb + 1024 + cc);
#pragma unroll
                for (int ai = 0; ai < 2; ++ai)
#pragma unroll
                    for (int m = 0; m < 4; ++m) { const int row = row0 + ai * HALF + m * 16; const unsigned off = (unsigned)row * ldc + cc;
                        const f32x4 s0 = *(const f32x4*)(out + off); const f32x2 st = *(const f32x2*)(stats + 2u * (unsigned)row);
                        const f32x4 o = ((s0 - st.x) * st.y * gv + bv) * sa + acc[ai][bj][m][n] * sb;
                        *(f32x4*)(out + off) = o;
                        if (OB) { u32x2 w; w.x = cvt_pk_bf16(o[0], o[1]); w.y = cvt_pk_bf16(o[2], o[3]); *(u32x2*)(ob + off) = w; } }
                asm volatile("" ::: "memory"); }
    }
};
struct EpiGate {
    static constexpr bool PERM = false, AFTER_DRAIN = false;
    float* R; const bf16_t* PP; const float* bias; int ldc;
    __device__ __forceinline__ void operator()(const f32x4 (&acc)[2][2][4][2], const Unit& u, int wr, int wc, int fr, int fq) const {
        const int row0 = u.pm * BM + wr * 64 + fr, col0 = u.pn * BM + wc * 32 + 4 * fq;
        f32x4 bv[2][2];
#pragma unroll
        for (int bj = 0; bj < 2; ++bj)
#pragma unroll
            for (int n = 0; n < 2; ++n) bv[bj][n] = *(const f32x4*)(bias + col0 + bj * HALF + n * 16);
#pragma unroll
        for (int ai = 0; ai < 2; ++ai)
#pragma unroll
            for (int m = 0; m < 4; ++m) { const size_t off = (size_t)(row0 + ai * HALF + m * 16) * ldc + col0;
#pragma unroll
                for (int bj = 0; bj < 2; ++bj)
#pragma unroll
                    for (int n = 0; n < 2; ++n) { const size_t o2 = off + bj * HALF + n * 16; const f32x4 s = *(const f32x4*)(R + o2); const u32x2 pw = *(const u32x2*)(PP + o2);
                        const f32x4 a = acc[ai][bj][m][n] + bv[bj][n]; f32x4 o;
                        o[0] = s[0] + fast_sigmoid(a[0]) * __uint_as_float(pw.x << 16); o[1] = s[1] + fast_sigmoid(a[1]) * __uint_as_float(pw.x & 0xffff0000u);
                        o[2] = s[2] + fast_sigmoid(a[2]) * __uint_as_float(pw.y << 16); o[3] = s[3] + fast_sigmoid(a[3]) * __uint_as_float(pw.y & 0xffff0000u);
                        *(f32x4*)(R + o2) = o; }
                asm volatile("" ::: "memory"); }
    }
};
template <class Epi, class Sched, bool STAMP = false>
__device__ __forceinline__ void gemm_phase(PG8_LAS unsigned char* lds, const Gemm g, const Sched& S, const Epi& E, unsigned long long* stamps) {
    int tid_l = threadIdx.x; asm volatile("" : "+v"(tid_l));
    const int tid = tid_l, wid = __builtin_amdgcn_readfirstlane(tid >> 6), lane = tid & 63, wr = wid >> 2, wc = wid & 3, fr = lane & 15, fq = lane >> 4;
    const int K = g.K, nt = K / BK;
    int ts_lo = 0, ts_hi = 0, nts = 0; const unsigned long long rt_entry = STAMP ? (unsigned long long)wall_clock64() : 0ull;
#define PG8_STAMP() do { if (STAMP && wid == 0 && nts < 64) { const unsigned long long _c = (unsigned long long)clock64(); \
        ts_lo = (lane == nts) ? (int)(unsigned)_c : ts_lo; ts_hi = (lane == nts) ? (int)(unsigned)(_c >> 32) : ts_hi; ++nts; } } while (0)
    PG8_STAMP();
    unsigned voffA[2], voffB[2];
#pragma unroll
    for (int i = 0; i < 2; ++i) { int R, C; stage_rc(tid * 16 + i * 8192, R, C); const int Rb = Epi::PERM ? ((R & ~31) + perm32(R & 31)) : R;
        voffA[i] = (unsigned)(R * K + C) * 2u; voffB[i] = (unsigned)(Rb * K + C) * 2u; }
    const size_t kstep = (size_t)(BK * 2);
    const size_t hstep = (size_t)HALF * K * 2;
    const size_t tstep = 2 * hstep;
    const unsigned ldsw = (unsigned)wid * 1024u;
    const int aoff = lds_byte(wr * 64 + fr, fq * 8), boff = lds_byte(wc * 32 + fr, fq * 8);
#define PG8_SA(b, h) (((b) * 2 + (h)) * HTB)
#define PG8_SB(b, h) ((4 + (b) * 2 + (h)) * HTB)
#define PG8_STAGE(bufoff, gbase, voff) do { _Pragma("unroll") for (int _i = 0; _i < 2; ++_i) \
        __builtin_amdgcn_global_load_lds((const unsigned*)((const char*)(gbase) + (voff)[_i]), (PG8_LAS unsigned*)(lds + (bufoff) + ldsw + _i * 8192), 16, 0, 0); } while (0)
#define PG8_LDA(dst, b, h) do { _Pragma("unroll") for (int m = 0; m < 4; ++m) _Pragma("unroll") for (int k = 0; k < 2; ++k) dst[m][k] = *(const PG8_LAS bf16x8*)(lds + PG8_SA(b, h) + aoff + m * 2048 + k * 1024); } while (0)
#define PG8_LDB(dst, b, h) do { _Pragma("unroll") for (int n = 0; n < 2; ++n) _Pragma("unroll") for (int k = 0; k < 2; ++k) dst[n][k] = *(const PG8_LAS bf16x8*)(lds + PG8_SB(b, h) + boff + n * 2048 + k * 1024); } while (0)
#define PG8_MMA(ai, bj, At, Bt) do { __builtin_amdgcn_s_setprio(1); _Pragma("unroll") for (int m = 0; m < 4; ++m) _Pragma("unroll") for (int n = 0; n < 2; ++n) _Pragma("unroll") for (int k = 0; k < 2; ++k) \
        acc[ai][bj][m][n] = __builtin_amdgcn_mfma_f32_16x16x32_bf16(Bt[n][k], At[m][k], acc[ai][bj][m][n], 0, 0, 0); __builtin_amdgcn_s_setprio(0); } while (0)
#define PG8_WAIT_V(n) asm volatile("s_waitcnt vmcnt(" #n ")" ::: "memory")
#define PG8_WAIT_L(n) asm volatile("s_waitcnt lgkmcnt(" #n ")" ::: "memory")
#define PG8_BAR __builtin_amdgcn_s_barrier()
#define PG8_SCHED __builtin_amdgcn_sched_barrier(0)
    Unit cur, nxt; int ui = 0;
    if (!S.next(0, cur)) return;
    f32x4 acc[2][2][4][2];
#pragma unroll
    for (int a = 0; a < 2; ++a)
#pragma unroll
        for (int b = 0; b < 2; ++b)
#pragma unroll
            for (int m = 0; m < 4; ++m)
#pragma unroll
                for (int n = 0; n < 2; ++n) acc[a][b][m][n] = (f32x4){0.f, 0.f, 0.f, 0.f};
    bf16x8 At[4][2], B0[2][2], B1[2][2];
    const char* cA = (const char*)g.A + (size_t)cur.pm * tstep; const char* cB = (const char*)g.Bt + (size_t)cur.pn * tstep;
    S.a_ready(cur);
    PG8_STAGE(PG8_SB(0, 0), cB, voffB); PG8_STAGE(PG8_SA(0, 0), cA, voffA); PG8_STAGE(PG8_SB(0, 1), cB + hstep, voffB); PG8_STAGE(PG8_SA(0, 1), cA + hstep, voffA);
    if (wr == 1) PG8_BAR;
    PG8_WAIT_V(4); PG8_BAR;
    PG8_STAGE(PG8_SB(1, 0), cB + kstep, voffB); PG8_STAGE(PG8_SA(1, 0), cA + kstep, voffA); PG8_STAGE(PG8_SB(1, 1), cB + hstep + kstep, voffB);
    PG8_WAIT_V(6); PG8_BAR;
    PG8_STAMP();
    for (;;) {
        const bool has_next = S.next(ui + 1, nxt);
        const char* nA = has_next ? (const char*)g.A + (size_t)nxt.pm * tstep : cA; const char* nB = has_next ? (const char*)g.Bt + (size_t)nxt.pn * tstep : cB;
        for (int t = 0; t < nt; t += 2) {
            const bool last = (t == nt - 2);
            const char* a1 = cA + (size_t)(t + 1) * kstep;
            const char* a2 = last ? nA : cA + (size_t)(t + 2) * kstep; const char* b2 = last ? nB : cB + (size_t)(t + 2) * kstep;
            const char* a3 = a2 + kstep; const char* b3 = b2 + kstep;
            if (last && has_next) S.a_ready(nxt);
            PG8_LDB(B0, 0, 0); PG8_SCHED; PG8_LDA(At, 0, 0); PG8_STAGE(PG8_SA(1, 1), a1 + hstep, voffA);
            PG8_WAIT_L(8); PG8_BAR; PG8_WAIT_L(0); PG8_MMA(0, 0, At, B0); PG8_BAR; PG8_SCHED;
            PG8_LDB(B1, 0, 1); PG8_STAGE(PG8_SB(0, 0), b2, voffB);
            PG8_BAR; PG8_WAIT_L(0); PG8_MMA(0, 1, At, B1); PG8_BAR;
            PG8_LDA(At, 0, 1); PG8_STAGE(PG8_SA(0, 0), a2, voffA);
            PG8_BAR; PG8_WAIT_L(0); PG8_MMA(1, 0, At, B0); PG8_BAR; PG8_SCHED;
            PG8_STAGE(PG8_SB(0, 1), b2 + hstep, voffB);
            PG8_WAIT_V(6); PG8_BAR; PG8_MMA(1, 1, At, B1); PG8_BAR;
            PG8_LDB(B0, 1, 0); PG8_SCHED; PG8_LDA(At, 1, 0); PG8_STAGE(PG8_SA(0, 1), a2 + hstep, voffA);
            PG8_WAIT_L(8); PG8_BAR; PG8_WAIT_L(0); PG8_MMA(0, 0, At, B0); PG8_BAR; PG8_SCHED;
            PG8_LDB(B1, 1, 1); PG8_STAGE(PG8_SB(1, 0), b3, voffB);
            PG8_BAR; PG8_WAIT_L(0); PG8_MMA(0, 1, At, B1); PG8_BAR;
            PG8_LDA(At, 1, 1); PG8_STAGE(PG8_SA(1, 0), a3, voffA);
            PG8_BAR; PG8_WAIT_L(0); PG8_MMA(1, 0, At, B0); PG8_BAR; PG8_SCHED;
            PG8_STAGE(PG8_SB(1, 1), b3 + hstep, voffB);
            PG8_WAIT_V(6); PG8_BAR; PG8_MMA(1, 1, At, B1); PG8_BAR;
        }
        PG8_STAMP();
        if constexpr (!Epi::AFTER_DRAIN) { E(acc, cur, wr, wc, fr, fq); S.done(cur); }
        PG8_STAMP();
        if (!has_next) break;
#pragma unroll
        for (int a = 0; a < 2; ++a)
#pragma unroll
            for (int b = 0; b < 2; ++b)
#pragma unroll
                for (int m = 0; m < 4; ++m)
#pragma unroll
                    for (int n = 0; n < 2; ++n) acc[a][b][m][n] = (f32x4){0.f, 0.f, 0.f, 0.f};
        cur = nxt; cA = nA; cB = nB; ++ui;
    }
    PG8_WAIT_V(0);
    if (wr == 0) PG8_BAR;
    PG8_BAR;
    if constexpr (Epi::AFTER_DRAIN) { E.fused(acc, cur, wr, wc, fr, fq, lds, wid, lane); S.done(cur); }
    PG8_STAMP();
    if (STAMP && wid == 0) { stamps[lane] = lane < nts ? (((unsigned long long)(unsigned)ts_hi << 32) | (unsigned)ts_lo) : 0ull;
        if (lane == 62) stamps[62] = rt_entry; if (lane == 63) stamps[63] = (unsigned long long)wall_clock64(); }
#undef PG8_STAMP
#undef PG8_SA
#undef PG8_SB
#undef PG8_STAGE
#undef PG8_LDA
#undef PG8_LDB
#undef PG8_MMA
#undef PG8_WAIT_V
#undef PG8_WAIT_L
#undef PG8_BAR
#undef PG8_SCHED
}
}

#define LAS __attribute__((address_space(3)))
typedef unsigned short bf16_t;
typedef short bf16x8 __attribute__((ext_vector_type(8)));
typedef float f32x4 __attribute__((ext_vector_type(4)));
typedef unsigned u32x4 __attribute__((ext_vector_type(4)));
typedef unsigned u32x2 __attribute__((ext_vector_type(2)));
typedef float f32x2s __attribute__((ext_vector_type(2)));

constexpr int MROWS = 66048, MP = 65536, DM = 1024, DFF = 2816, NIN = 2816, NHEAD = 12;
constexpr float ALPHA_F = 1.4142135623730951f;
constexpr int LDS_XB = 156992;
constexpr int LDS_BYTES = 157056;
constexpr int NTHREADS = 512;
constexpr size_t WT_FFN1IN = 0, WT_FFN1OUT = 5767168, WT_WIN = 8650752, WT_POOL = 11534336, WT_WOUT = 11599872, WT_FFN2IN = 12648448, WT_FFN2OUT = 18415616,
                 WT_GATE = 21299200, WT_PLE = 22347776, WT_LAYER = 22609920;
constexpr size_t OFF_WT = 0, OFF_R = 90439680, OFF_XB = 360972288, OFF_HZ = 496238592, OFF_PB = 868220928, OFF_PP = 935854080, OFF_STATS = 1071120384, OFF_GB = 1071648768, OFF_BAR = 1071697920, WS_END = 1071711744;
constexpr size_t O_YP = 0, O_YS = 67108864, O_PP = 67633152, O_SP = 67756032, O_WP = 67837952, O_PS = 69410816, O_SS = 69533696, O_WS = 69615616;

struct Params { const float* in[35]; float* out; unsigned char* ws; };

__device__ __forceinline__ float bf_lo(unsigned w) { return __uint_as_float(w << 16); }
__device__ __forceinline__ float bf_hi(unsigned w) { return __uint_as_float(w & 0xffff0000u); }
__device__ __forceinline__ unsigned short f2bf(float f) { return (unsigned short)(pg8::cvt_pk_bf16(f, 0.f) & 0xffffu); }
__device__ __forceinline__ float wave_sum(float v) {
#pragma unroll
    for (int o = 32; o >= 1; o >>= 1) v += __shfl_xor(v, o);
    return v;
}
__device__ __forceinline__ const Params& fresh_params() { auto k = __builtin_amdgcn_kernarg_segment_ptr(); asm volatile("" : "+s"(k)); return *(const Params*)k; }
__device__ __forceinline__ int fresh_tid() { int t = threadIdx.x; asm volatile("" : "+v"(t)); return t; }
template <int CTRL> __device__ __forceinline__ float dpp_mov(float v) { return __builtin_bit_cast(float, __builtin_amdgcn_update_dpp(0, __builtin_bit_cast(int, v), CTRL, 0xF, 0xF, true)); }
__device__ __forceinline__ float allreduce8(float v) { v += dpp_mov<0xB1>(v); v += dpp_mov<0x4E>(v); v += dpp_mov<0x141>(v); return v; }
__device__ __forceinline__ float fsig(float x) { return __builtin_amdgcn_rcpf(1.0f + __builtin_amdgcn_exp2f(-1.4426950408889634f * x)); }
__device__ __forceinline__ float ftanh(float x) { return 1.0f - 2.0f * __builtin_amdgcn_rcpf(1.0f + __builtin_amdgcn_exp2f(2.8853900817779268f * x)); }

__device__ __forceinline__ void convert_weight(const float* src, int K, int Nsrc, int Nd, int mode, bf16_t* dst, LAS float* tile) {
    const int tid = fresh_tid(), ntn = Nd / 64, ntk = K / 64;
    for (int t = blockIdx.x; t < ntn * ntk; t += gridDim.x) {
        const int tn = t % ntn, tk = t / ntn, n0 = tn * 64, k0 = tk * 64;
        int c0 = n0;
        if (mode == 1) { const int pn = n0 >> 8, w = n0 & 255; c0 = (w < 128) ? (128 * pn + w) : (DFF + 128 * pn + (w - 128)); }
#pragma unroll
        for (int i = 0; i < 2; ++i) { const int kk = (tid >> 4) + 32 * i, c4 = tid & 15;
            const f32x4 v = *(const f32x4*)(src + (size_t)(k0 + kk) * Nsrc + c0 + 4 * c4);
            tile[kk * 65 + 4 * c4 + 0] = v[0]; tile[kk * 65 + 4 * c4 + 1] = v[1]; tile[kk * 65 + 4 * c4 + 2] = v[2]; tile[kk * 65 + 4 * c4 + 3] = v[3]; }
        __syncthreads();
        { const int n = tid >> 3, k8 = tid & 7; float f[8];
#pragma unroll
            for (int j = 0; j < 8; ++j) f[j] = tile[(k8 * 8 + j) * 65 + n];
            u32x4 w; w.x = pg8::cvt_pk_bf16(f[0], f[1]); w.y = pg8::cvt_pk_bf16(f[2], f[3]); w.z = pg8::cvt_pk_bf16(f[4], f[5]); w.w = pg8::cvt_pk_bf16(f[6], f[7]);
            *(u32x4*)(dst + (size_t)(n0 + n) * K + k0 + k8 * 8) = w; }
        __syncthreads();
    }
}
__device__ __forceinline__ void prologue(LAS unsigned char* lds) {
    const Params& p = fresh_params();
    LAS float* tile = (LAS float*)lds;
    bf16_t* WT = (bf16_t*)(p.ws + OFF_WT);
    for (int l = 0; l < 2; ++l) {
        bf16_t* W = WT + (size_t)l * WT_LAYER;
        convert_weight(p.in[13] + (size_t)l * DM * 2 * DFF, DM, 2 * DFF, 2 * DFF, 1, W + WT_FFN1IN, tile);
        convert_weight(p.in[14] + (size_t)l * DFF * DM, DFF, DM, DM, 0, W + WT_FFN1OUT, tile);
        convert_weight(p.in[17] + (size_t)l * DM * NIN, DM, NIN, NIN, 0, W + WT_WIN, tile);
        convert_weight(p.in[31] + (size_t)l * DM * DM, DM, DM, DM, 0, W + WT_WOUT, tile);
        convert_weight(p.in[15] + (size_t)l * DM * 2 * DFF, DM, 2 * DFF, 2 * DFF, 1, W + WT_FFN2IN, tile);
        convert_weight(p.in[16] + (size_t)l * DFF * DM, DFF, DM, DM, 0, W + WT_FFN2OUT, tile);
        convert_weight(p.in[32] + (size_t)l * DM * DM, DM, DM, DM, 0, W + WT_GATE, tile);
        convert_weight(p.in[34] + (size_t)l * 256 * DM, 256, DM, DM, 0, W + WT_PLE, tile);
        const float* pw = p.in[19] + (size_t)l * 4 * 64 * 64;
        for (int i = blockIdx.x * NTHREADS + fresh_tid(); i < 256 * 256; i += gridDim.x * NTHREADS) {
            const int n = i >> 8, k = i & 255, g = n >> 6, d = n & 63, g2 = k >> 6, c = k & 63;
            W[WT_POOL + i] = (g == g2) ? f2bf(pw[(g * 64 + c) * 64 + d]) : (bf16_t)0;
        }
    }
    { float* GBw = (float*)(p.ws + OFF_GB);
      for (int i = blockIdx.x * NTHREADS + fresh_tid(); i < 2 * 3 * 2048; i += gridDim.x * NTHREADS) {
          const int l = i / 6144, j = (i % 6144) / 2048, e = i % 2048;
          GBw[i] = p.in[7 + 2 * j + (e >> 10)][l * DM + (e & 1023)]; } }
    bf16_t* XB = (bf16_t*)(p.ws + OFF_XB);
    const size_t gt = (size_t)blockIdx.x * NTHREADS + fresh_tid(), gs = (size_t)gridDim.x * NTHREADS;
    for (size_t i = gt; i < (size_t)MROWS * DM / 8; i += gs) {
        const size_t e = i * 8; const float* s = (e < (size_t)MP * DM) ? p.in[0] + e : p.in[1] + (e - (size_t)MP * DM);
        const f32x4 a = *(const f32x4*)s, b = *(const f32x4*)(s + 4);
        u32x4 w; w.x = pg8::cvt_pk_bf16(a[0], a[1]); w.y = pg8::cvt_pk_bf16(a[2], a[3]); w.z = pg8::cvt_pk_bf16(b[0], b[1]); w.w = pg8::cvt_pk_bf16(b[2], b[3]);
        *(u32x4*)(XB + e) = w;
    }
    bf16_t* PB = (bf16_t*)(p.ws + OFF_PB);
    for (size_t i = gt; i < (size_t)2 * MROWS * 256 / 8; i += gs) {
        const size_t e = i * 8; const int l = (int)(e / ((size_t)MROWS * 256)); const size_t r = e - (size_t)l * MROWS * 256;
        const float* s = (r < (size_t)MP * 256) ? p.in[2] + (size_t)l * MP * 256 + r : p.in[3] + (size_t)l * 512 * 256 + (r - (size_t)MP * 256);
        const f32x4 a = *(const f32x4*)s, b = *(const f32x4*)(s + 4);
        u32x4 w; w.x = pg8::cvt_pk_bf16(a[0], a[1]); w.y = pg8::cvt_pk_bf16(a[2], a[3]); w.z = pg8::cvt_pk_bf16(b[0], b[1]); w.w = pg8::cvt_pk_bf16(b[2], b[3]);
        *(u32x4*)(PB + e) = w;
    }
}

__device__ __forceinline__ void ln_row(int row, int lane, float* R, const f32x4 (&gv)[4], const f32x4 (&bv)[4], bf16_t* xb, float* outp, float* outs, float* stats) {
    float* rp = R + (size_t)row * DM;
    f32x4 v[4]; float s = 0.f;
#pragma unroll
    for (int i = 0; i < 4; ++i) { v[i] = *(const f32x4*)(rp + i * 256 + lane * 4); s += (v[i][0] + v[i][1]) + (v[i][2] + v[i][3]); }
    const float mean = wave_sum(s) * (1.0f / 1024.0f);
    float q = 0.f;
#pragma unroll
    for (int i = 0; i < 4; ++i) { v[i] = v[i] - mean; q += (v[i][0] * v[i][0] + v[i][1] * v[i][1]) + (v[i][2] * v[i][2] + v[i][3] * v[i][3]); }
    const float rstd = 1.0f / sqrtf(wave_sum(q) * (1.0f / 1024.0f) + 1e-5f);
    float* op = outp ? ((row < MP) ? outp + (size_t)row * DM : outs + (size_t)(row - MP) * DM) : rp;
    if (stats && lane == 0) *(f32x2s*)(stats + 2 * (size_t)row) = (f32x2s){mean, rstd};
#pragma unroll
    for (int i = 0; i < 4; ++i) { const f32x4 y = v[i] * rstd * gv[i] + bv[i];
        if (!stats) *(f32x4*)(op + i * 256 + lane * 4) = y;
        if (xb) { u32x2 w; w.x = pg8::cvt_pk_bf16(y[0], y[1]); w.y = pg8::cvt_pk_bf16(y[2], y[3]); *(u32x2*)(xb + (size_t)row * DM + i * 256 + lane * 4) = w; } }
}
__device__ __forceinline__ void ln_tiles(int part, float* R, const float* g, const float* b, bf16_t* xb, float* outp, float* outs, float* stats) {
    const int tid = fresh_tid(), lane = tid & 63, wave = tid >> 6;
    int s0, s1, s2, s3, s4, s5, s6, s7;
    { pg8::StaticOrder S8; pg8::Unit u8;
      S8.init(MROWS, DM, 256, 0); S8.next(4, u8); s0 = u8.pm; S8.init(MROWS, DM, 256, 1); S8.next(4, u8); s1 = u8.pm; S8.init(MROWS, DM, 256, 2); S8.next(4, u8); s2 = u8.pm; S8.init(MROWS, DM, 256, 3); S8.next(4, u8); s3 = u8.pm;
      S8.init(MROWS, DM, 256, 4); S8.next(4, u8); s4 = u8.pm; S8.init(MROWS, DM, 256, 5); S8.next(4, u8); s5 = u8.pm; S8.init(MROWS, DM, 256, 6); S8.next(4, u8); s6 = u8.pm; S8.init(MROWS, DM, 256, 7); S8.next(4, u8); s7 = u8.pm; }
    f32x4 gv[4], bv[4];
#pragma unroll
    for (int i = 0; i < 4; ++i) { gv[i] = *(const f32x4*)(g + i * 256 + lane * 4); bv[i] = *(const f32x4*)(b + i * 256 + lane * 4); }
    if (part == 0) {
        const int wg = (int)blockIdx.x - 8, nwg = (int)gridDim.x - 8;
        for (int row = wg * 8 + wave; row < MROWS; row += nwg * 8) {
            const int t = row >> 8;
            if (t == s0 || t == s1 || t == s2 || t == s3 || t == s4 || t == s5 || t == s6 || t == s7) continue;
            ln_row(row, lane, R, gv, bv, xb, outp, outs, stats);
        }
    } else {
        for (int idx = blockIdx.x * 8 + wave; idx < 8 * 256; idx += gridDim.x * 8) {
            const int j = idx >> 8, t = j == 0 ? s0 : j == 1 ? s1 : j == 2 ? s2 : j == 3 ? s3 : j == 4 ? s4 : j == 5 ? s5 : j == 6 ? s6 : s7;
            ln_row(t * 256 + (idx & 255), lane, R, gv, bv, xb, outp, outs, stats);
        }
    }
}
__device__ __forceinline__ void ln_phase(float* R, const float* g, const float* b, bf16_t* xb, float* outp, float* outs, float* stats) {
    const int tid = fresh_tid(), lane = tid & 63, wave = tid >> 6;
    f32x4 gv[4], bv[4];
#pragma unroll
    for (int i = 0; i < 4; ++i) { gv[i] = *(const f32x4*)(g + i * 256 + lane * 4); bv[i] = *(const f32x4*)(b + i * 256 + lane * 4); }
    for (int row = blockIdx.x * 8 + wave; row < MROWS; row += gridDim.x * 8) {
        float* rp = R + (size_t)row * DM;
        f32x4 v[4]; float s = 0.f;
#pragma unroll
        for (int i = 0; i < 4; ++i) { v[i] = *(const f32x4*)(rp + i * 256 + lane * 4); s += (v[i][0] + v[i][1]) + (v[i][2] + v[i][3]); }
        const float mean = wave_sum(s) * (1.0f / 1024.0f);
        float q = 0.f;
#pragma unroll
        for (int i = 0; i < 4; ++i) { v[i] = v[i] - mean; q += (v[i][0] * v[i][0] + v[i][1] * v[i][1]) + (v[i][2] * v[i][2] + v[i][3] * v[i][3]); }
        const float rstd = 1.0f / sqrtf(wave_sum(q) * (1.0f / 1024.0f) + 1e-5f);
        float* op = outp ? ((row < MP) ? outp + (size_t)row * DM : outs + (size_t)(row - MP) * DM) : rp;
        if (stats && lane == 0) *(f32x2s*)(stats + 2 * (size_t)row) = (f32x2s){mean, rstd};
#pragma unroll
        for (int i = 0; i < 4; ++i) { const f32x4 y = v[i] * rstd * gv[i] + bv[i];
            if (!stats) *(f32x4*)(op + i * 256 + lane * 4) = y;
            if (xb) { u32x2 w; w.x = pg8::cvt_pk_bf16(y[0], y[1]); w.y = pg8::cvt_pk_bf16(y[2], y[3]); *(u32x2*)(xb + (size_t)row * DM + i * 256 + lane * 4) = w; } }
    }
}

__device__ __forceinline__ void mixprep_phase(int l, const bf16_t* Z, bf16_t* pooled, bf16_t* lora_a) {
    const Params& p = fresh_params();
    const size_t gt = (size_t)blockIdx.x * NTHREADS + fresh_tid(), gs = (size_t)gridDim.x * NTHREADS;
    const float* hist_all = p.in[4] + (size_t)l * 16 * 15 * 256;
    for (size_t task = gt; task < (size_t)MROWS * 32; task += gs) {
        const int row = (int)(task >> 5), c8 = (int)(task & 31), col = c8 * 8, w = 2 << (c8 >> 3);
        const bool samp = row >= MP; const int b = samp ? ((row - MP) >> 5) : (row >> 12), t = samp ? ((row - MP) & 31) : (row & 4095);
        float acc[8], u0[8];
#pragma unroll
        for (int j = 0; j < 8; ++j) acc[j] = 0.f;
        for (int d = 0; d < w; ++d) {
            const int tt = t - d;
            if (tt >= 0) { const u32x4 q = *(const u32x4*)(Z + (size_t)(row - d) * NIN + col);
                const float f0 = bf_lo(q.x), f1 = bf_hi(q.x), f2 = bf_lo(q.y), f3 = bf_hi(q.y), f4 = bf_lo(q.z), f5 = bf_hi(q.z), f6 = bf_lo(q.w), f7 = bf_hi(q.w);
                if (d == 0) { u0[0] = f0; u0[1] = f1; u0[2] = f2; u0[3] = f3; u0[4] = f4; u0[5] = f5; u0[6] = f6; u0[7] = f7; }
                acc[0] += f0; acc[1] += f1; acc[2] += f2; acc[3] += f3; acc[4] += f4; acc[5] += f5; acc[6] += f6; acc[7] += f7; }
            else if (samp) { const float* hp = hist_all + ((size_t)b * 15 + (15 + tt)) * 256 + col; const f32x4 a = *(const f32x4*)hp, c = *(const f32x4*)(hp + 4);
                acc[0] += a[0]; acc[1] += a[1]; acc[2] += a[2]; acc[3] += a[3]; acc[4] += c[0]; acc[5] += c[1]; acc[6] += c[2]; acc[7] += c[3]; }
        }
        const float inv = 1.0f / (float)(samp ? w : ((t + 1 < w) ? (t + 1) : w));
        u32x4 o; o.x = pg8::cvt_pk_bf16(acc[0] * inv - u0[0], acc[1] * inv - u0[1]); o.y = pg8::cvt_pk_bf16(acc[2] * inv - u0[2], acc[3] * inv - u0[3]);
        o.z = pg8::cvt_pk_bf16(acc[4] * inv - u0[4], acc[5] * inv - u0[5]); o.w = pg8::cvt_pk_bf16(acc[6] * inv - u0[6], acc[7] * inv - u0[7]);
        *(u32x4*)(pooled + (size_t)row * 256 + col) = o;
        const int T = samp ? 32 : 4096;
        if (t >= T - 15) { float* op = p.out + (samp ? O_PS : O_PP) + (((size_t)l * 16 + b) * 15 + (t - (T - 15))) * 256 + col;
            *(f32x4*)op = (f32x4){u0[0], u0[1], u0[2], u0[3]}; *(f32x4*)(op + 4) = (f32x4){u0[4], u0[5], u0[6], u0[7]}; }
    }
    {
        const float* mu = p.in[18] + (size_t)l * 2560 + 2304;
        for (size_t task = gt; task < (size_t)MROWS * 32; task += gs) {
            const int row = (int)(task >> 5), q8 = (int)(task & 31), col = q8 * 8;
            const bool samp = row >= MP; const int b = samp ? ((row - MP) >> 5) : (row >> 12), t = samp ? ((row - MP) & 31) : (row & 4095);
            const u32x4 q = *(const u32x4*)(Z + (size_t)row * NIN + 256 + 2304 + col);
            float cur[8] = {bf_lo(q.x), bf_hi(q.x), bf_lo(q.y), bf_hi(q.y), bf_lo(q.z), bf_hi(q.z), bf_lo(q.w), bf_hi(q.w)};
            float prv[8];
            if (t > 0) { const u32x4 r = *(const u32x4*)(Z + (size_t)(row - 1) * NIN + 256 + 2304 + col);
                prv[0] = bf_lo(r.x); prv[1] = bf_hi(r.x); prv[2] = bf_lo(r.y); prv[3] = bf_hi(r.y); prv[4] = bf_lo(r.z); prv[5] = bf_hi(r.z); prv[6] = bf_lo(r.w); prv[7] = bf_hi(r.w); }
            else if (samp) { const float* sp = p.in[5] + ((size_t)l * 16 + b) * 2560 + 2304 + col; const f32x4 x = *(const f32x4*)sp, y = *(const f32x4*)(sp + 4);
                prv[0] = x[0]; prv[1] = x[1]; prv[2] = x[2]; prv[3] = x[3]; prv[4] = y[0]; prv[5] = y[1]; prv[6] = y[2]; prv[7] = y[3]; }
            else {
#pragma unroll
                for (int j = 0; j < 8; ++j) prv[j] = 0.f; }
            const f32x4 m0 = *(const f32x4*)(mu + col), m1 = *(const f32x4*)(mu + col + 4);
            float zs[8];
#pragma unroll
            for (int j = 0; j < 8; ++j) { zs[j] = cur[j] + (prv[j] - cur[j]) * (j < 4 ? m0[j] : m1[j - 4]); }
            if (q8 < 8) {
#pragma unroll
                for (int j = 0; j < 8; ++j) zs[j] = ftanh(zs[j]); }
            else if (q8 >= 16) {
#pragma unroll
                for (int j = 0; j < 8; ++j) zs[j] = fsig(zs[j]); }
            u32x4 w; w.x = pg8::cvt_pk_bf16(zs[0], zs[1]); w.y = pg8::cvt_pk_bf16(zs[2], zs[3]); w.z = pg8::cvt_pk_bf16(zs[4], zs[5]); w.w = pg8::cvt_pk_bf16(zs[6], zs[7]);
            *(u32x4*)(lora_a + (size_t)row * 256 + col) = w;
        }
    }
    for (size_t i = gt; i < (size_t)32 * 2560; i += gs) {
        const int s = (int)(i / 2560), c = (int)(i % 2560); const bool samp = s >= 16; const int b = s & 15;
        const int row = samp ? (MP + b * 32 + 31) : (b * 4096 + 4095);
        p.out[(samp ? O_SS : O_SP) + ((size_t)l * 16 + b) * 2560 + c] = __uint_as_float((unsigned)Z[(size_t)row * NIN + 256 + c] << 16);
    }
}

constexpr int TC = 16;
constexpr int RS = 68;
constexpr int MS = 20;
constexpr int NBUF = 4;
constexpr int B_R = 0, B_K = 4352, B_V = 8704, B_A = 13056, B_B = 17408, B_G = 21760, B_Y = 25856, B_PC = 29952, B_BON = 30208, BUFSZ = 30272;
constexpr int SC_W2 = 121088, SC_A2 = 130304, SC_G2 = 139520, SC_CTR = 156928;
constexpr int XS = 72, XGS = 136;
typedef float f32x2 __attribute__((ext_vector_type(2)));
__device__ __forceinline__ float rowsum16(float v) { v += dpp_mov<0xB1>(v); v += dpp_mov<0x4E>(v); v += dpp_mov<0x141>(v); v += dpp_mov<0x140>(v); return v; }
template <int CTRL> __device__ __forceinline__ float dpp_shr1(float v) { return __builtin_bit_cast(float, __builtin_amdgcn_update_dpp(0x3f800000, __builtin_bit_cast(int, v), CTRL, 0xF, 0xF, false)); }
__device__ __forceinline__ float rowprefix_mul(float p) { p *= dpp_shr1<0x111>(p); p *= dpp_shr1<0x112>(p); p *= dpp_shr1<0x114>(p); p *= dpp_shr1<0x118>(p); return p; }
__device__ __forceinline__ void lds_wait_ge(LAS unsigned* ctr, unsigned want) {
    while (__hip_atomic_load(ctr, __ATOMIC_ACQUIRE, __HIP_MEMORY_SCOPE_WORKGROUP) < want) __builtin_amdgcn_s_sleep(1);
}
__device__ __forceinline__ void prep_bar(LAS unsigned* ctr, unsigned& gen, int lane) {
    gen += 4u;
    if (lane == 0) __hip_atomic_fetch_add(ctr, 1u, __ATOMIC_RELEASE, __HIP_MEMORY_SCOPE_WORKGROUP);
    while (__hip_atomic_load(ctr, __ATOMIC_ACQUIRE, __HIP_MEMORY_SCOPE_WORKGROUP) < gen) {}
}
#define MFMA4(a, b, c) __builtin_amdgcn_mfma_f32_16x16x4f32((a), (b), (c), 0, 0, 0)
#define MFMAB(a, b, c) __builtin_amdgcn_mfma_f32_16x16x32_bf16((a), (b), (c), 0, 0, 0)
__device__ __forceinline__ bf16x8 cvt4z(f32x4 lo) { u32x4 w; w.x = pg8::cvt_pk_bf16(lo[0], lo[1]); w.y = pg8::cvt_pk_bf16(lo[2], lo[3]); w.z = 0u; w.w = 0u; return __builtin_bit_cast(bf16x8, w); }
__device__ __forceinline__ bf16x8 cvt8(f32x4 lo, f32x4 hi) { u32x4 w; w.x = pg8::cvt_pk_bf16(lo[0], lo[1]); w.y = pg8::cvt_pk_bf16(lo[2], lo[3]); w.z = pg8::cvt_pk_bf16(hi[0], hi[1]); w.w = pg8::cvt_pk_bf16(hi[2], hi[3]); return __builtin_bit_cast(bf16x8, w); }

__device__ __forceinline__ void scan_phase(int l, const bf16_t* Z, const bf16_t* lora_a, bf16_t* mixin, LAS unsigned char* lds) {
    const Params& p = fresh_params();
    const int tid = fresh_tid(), lane = tid & 63, wave = __builtin_amdgcn_readfirstlane(tid >> 6);
    LAS bf16_t* w2t = (LAS bf16_t*)(lds + SC_W2); LAS bf16_t* a2t = (LAS bf16_t*)(lds + SC_A2); LAS bf16_t* g2t = (LAS bf16_t*)(lds + SC_G2);
    LAS unsigned* ctr = (LAS unsigned*)(lds + SC_CTR);
    const float* mu = p.in[18] + (size_t)l * 2560;
    const int fr = lane & 15, fq = lane >> 4;
    for (int unit = blockIdx.x; unit < 384; unit += gridDim.x) {
        const bool samp = unit >= 192; const int uu = samp ? unit - 192 : unit, b = uu / 12, h = uu % 12;
        const int T = samp ? 32 : 4096, row0 = samp ? (MP + b * 32) : (b * 4096), NC = T / TC;
        __syncthreads();
        for (int i = tid; i < 64 * 64; i += NTHREADS) { const int k = i >> 6, n = i & 63;
            w2t[n * XS + k] = f2bf(p.in[22][((size_t)l * 64 + k) * 768 + h * 64 + n]);
            a2t[n * XS + k] = f2bf(p.in[24][((size_t)l * 64 + k) * 768 + h * 64 + n]); }
        for (int i = tid; i < 128 * 64; i += NTHREADS) { const int k = i >> 6, n = i & 63;
            g2t[n * XGS + k] = f2bf(p.in[25][((size_t)l * 128 + k) * 768 + h * 64 + n]); }
        if (tid < 8) ctr[tid] = 0u;
        __syncthreads();
        if (wave < 4) {
            const int vt = wave;
            f32x4 H0, H1, H2, H3;
            const size_t sbase = ((((size_t)l * 16 + b) * 12 + h) * 64 + vt * 16 + fr) * 64 + 4 * fq;
            if (samp) { const float* sp = p.in[6] + sbase; H0 = *(const f32x4*)sp; H1 = *(const f32x4*)(sp + 16); H2 = *(const f32x4*)(sp + 32); H3 = *(const f32x4*)(sp + 48); }
            else { H0 = (f32x4){0.f, 0.f, 0.f, 0.f}; H1 = H0; H2 = H0; H3 = H0; }
            asm volatile("" : "+v"(H0), "+v"(H1), "+v"(H2), "+v"(H3));
#pragma unroll 1
            for (int c = 0; c < NC; ++c) {
                const int bi = c % NBUF;
                lds_wait_ge(ctr + bi, (unsigned)(c + 1));
                LAS unsigned char* bb = lds + bi * BUFSZ;
                const LAS float* opR = (const LAS float*)(bb + B_R); const LAS float* opK = (const LAS float*)(bb + B_K); const LAS float* opV = (const LAS float*)(bb + B_V);
                const LAS float* opA = (const LAS float*)(bb + B_A); const LAS float* opB = (const LAS float*)(bb + B_B); LAS float* yB = (LAS float*)(bb + B_Y);
                const int ro = fr * RS + 4 * fq;
                const f32x4 a0 = *(const LAS f32x4*)(opA + ro), a1 = *(const LAS f32x4*)(opA + ro + 16), a2 = *(const LAS f32x4*)(opA + ro + 32), a3 = *(const LAS f32x4*)(opA + ro + 48);
                const f32x4 r0 = *(const LAS f32x4*)(opR + ro), r1 = *(const LAS f32x4*)(opR + ro + 16), r2 = *(const LAS f32x4*)(opR + ro + 32), r3 = *(const LAS f32x4*)(opR + ro + 48);
                const f32x4 b0 = *(const LAS f32x4*)(opB + ro), b1 = *(const LAS f32x4*)(opB + ro + 16), b2 = *(const LAS f32x4*)(opB + ro + 32), b3 = *(const LAS f32x4*)(opB + ro + 48);
                const f32x4 k0 = *(const LAS f32x4*)(opK + ro), k1 = *(const LAS f32x4*)(opK + ro + 16), k2 = *(const LAS f32x4*)(opK + ro + 32), k3 = *(const LAS f32x4*)(opK + ro + 48);
                f32x4 W = {0.f, 0.f, 0.f, 0.f}, Y = W;
                f32x4 LA = W, LD = W, KA = W, NbA = W, NkA = W;
                { const bf16x8 hb0 = cvt8(H0, H1), hb1 = cvt8(H2, H3);
                    const bf16x8 fa0 = cvt8(a0, a1), fa1 = cvt8(a2, a3), fr0 = cvt8(r0, r1), fr1 = cvt8(r2, r3);
                    const bf16x8 fb0 = cvt8(b0, b1), fb1 = cvt8(b2, b3), fk0 = cvt8(k0, k1), fk1 = cvt8(k2, k3);
                    W = MFMAB(fa0, hb0, W); W = MFMAB(fa1, hb1, W);
                    Y = MFMAB(fr0, hb0, Y); Y = MFMAB(fr1, hb1, Y);
                    LA = MFMAB(fb0, fa0, LA); LA = MFMAB(fb1, fa1, LA);
                    LD = MFMAB(fa0, fb0, LD); LD = MFMAB(fa1, fb1, LD);
                    KA = MFMAB(fk0, fa0, KA); KA = MFMAB(fk1, fa1, KA);
                    NbA = MFMAB(fb0, fr0, NbA); NbA = MFMAB(fb1, fr1, NbA);
                    NkA = MFMAB(fk0, fr0, NkA); NkA = MFMAB(fk1, fr1, NkA);
                }
#pragma unroll
                for (int j = 0; j < 4; ++j) { const int sA = 4 * fq + j;
                    LA[j] = (sA < fr) ? LA[j] : 0.f; KA[j] = (sA < fr) ? KA[j] : 0.f; NbA[j] = (sA <= fr) ? NbA[j] : 0.f; NkA[j] = (sA <= fr) ? NkA[j] : 0.f;
                    LD[j] = (fr < sA) ? LD[j] : 0.f; }
                const f32x4 Z4 = {0.f, 0.f, 0.f, 0.f};
                const bf16x8 fLA = cvt4z(LA), fLD = cvt4z(LD);
                const f32x4 L2A = MFMAB(fLD, fLA, Z4), L2D = MFMAB(fLA, fLD, Z4);
                const bf16x8 fL2A = cvt4z(L2A), fL2D = cvt4z(L2D);
                const f32x4 L4A = MFMAB(fL2D, fL2A, Z4), L4D = MFMAB(fL2A, fL2D, Z4);
                const bf16x8 fL4A = cvt4z(L4A), fL4D = cvt4z(L4D);
                const f32x4 L8A = MFMAB(fL4D, fL4A, Z4);
                f32x4 Vr;
#pragma unroll
                for (int j = 0; j < 4; ++j) Vr[j] = opV[(4 * fq + j) * RS + vt * 16 + fr];
                W = MFMAB(cvt4z(KA), cvt4z(Vr), W);
                W = MFMAB(fLA, cvt4z(W), W);
                W = MFMAB(fL2A, cvt4z(W), W);
                W = MFMAB(fL4A, cvt4z(W), W);
                W = MFMAB(cvt4z(L8A), cvt4z(W), W);
                const bf16x8 uvb = cvt8(W, Vr);
                Y = MFMAB(cvt8(NbA, NkA), uvb, Y);
#pragma unroll
                for (int j = 0; j < 4; ++j) yB[(4 * fq + j) * 64 + vt * 16 + fr] = Y[j];
                {
                    f32x4 bq0, bq1, bq2, bq3, kq0, kq1, kq2, kq3;
#pragma unroll
                    for (int j = 0; j < 4; ++j) { const int o = (4 * fq + j) * RS + fr;
                        bq0[j] = opB[o]; bq1[j] = opB[o + 16]; bq2[j] = opB[o + 32]; bq3[j] = opB[o + 48];
                        kq0[j] = opK[o]; kq1[j] = opK[o + 16]; kq2[j] = opK[o + 32]; kq3[j] = opK[o + 48]; }
                    H0 = MFMAB(cvt8(bq0, kq0), uvb, H0); H1 = MFMAB(cvt8(bq1, kq1), uvb, H1); H2 = MFMAB(cvt8(bq2, kq2), uvb, H2); H3 = MFMAB(cvt8(bq3, kq3), uvb, H3);
                }
                { const LAS float* pc = (const LAS float*)(bb + B_PC) + 4 * fq;
                    H0 = H0 * *(const LAS f32x4*)pc; H1 = H1 * *(const LAS f32x4*)(pc + 16); H2 = H2 * *(const LAS f32x4*)(pc + 32); H3 = H3 * *(const LAS f32x4*)(pc + 48); }
                if (lane == 0) __hip_atomic_store(ctr + 4 + vt, (unsigned)(c + 1), __ATOMIC_RELEASE, __HIP_MEMORY_SCOPE_WORKGROUP);
            }
            { float* sp = p.out + (samp ? O_WS : O_WP) + sbase; *(f32x4*)sp = H0; *(f32x4*)(sp + 16) = H1; *(f32x4*)(sp + 32) = H2; *(f32x4*)(sp + 48) = H3; }
        } else {
            const int pw = wave - 4;
            __builtin_amdgcn_s_setprio(2);
            const int ecg = lane & 15;
            const int hc4 = l * 768 + h * 64 + 4 * ecg;
            const f32x4 c_kk = *(const f32x4*)(p.in[26] + hc4), c_ka = *(const f32x4*)(p.in[27] + hc4), c_rk = *(const f32x4*)(p.in[28] + hc4);
            const f32x4 c_lg = *(const f32x4*)(p.in[29] + hc4), c_lb = *(const f32x4*)(p.in[30] + hc4);
            f32x4 cw0, ca0;
#pragma unroll
            for (int nt = 0; nt < 4; ++nt) { cw0[nt] = p.in[21][l * 768 + h * 64 + nt * 16 + fr]; ca0[nt] = p.in[23][l * 768 + h * 64 + nt * 16 + fr]; }
            const int cc = lane;
            const bool act1 = cc < 24;
            const int zc = ((act1 ? cc : 23) >> 3) * 768 + h * 64 + (cc & 7) * 8;
            const f32x4 m0 = *(const f32x4*)(mu + zc), m1 = *(const f32x4*)(mu + zc + 4);
            const bf16_t* zbase = Z + (size_t)row0 * NIN + 256 + zc;
            LAS unsigned char* bb = lds + pw * BUFSZ;
            LAS float* opR = (LAS float*)(bb + B_R); LAS float* opK = (LAS float*)(bb + B_K); LAS float* opV = (LAS float*)(bb + B_V);
            LAS float* opA = (LAS float*)(bb + B_A); LAS float* opB = (LAS float*)(bb + B_B); LAS float* gV = (LAS float*)(bb + B_G); LAS float* aL = (LAS float*)(bb + B_Y);
#define LDS_FENCE() asm volatile("s_waitcnt lgkmcnt(0)" ::: "memory")
            f32x4 pv0 = {0.f, 0.f, 0.f, 0.f}, pv1 = pv0;
            if (samp) { const float* sp = p.in[5] + ((size_t)l * 16 + b) * 2560 + zc; pv0 = *(const f32x4*)sp; pv1 = *(const f32x4*)(sp + 4); }
            asm volatile("" : "+v"(pv0), "+v"(pv1));
            u32x4 qq[16], qprev = {0u, 0u, 0u, 0u};
#pragma unroll
            for (int i = 0; i < 16; ++i) qq[i] = qprev;
            { const int c0 = pw < NC ? pw : NC - 1; const bf16_t* zp = zbase + (size_t)(c0 * TC) * NIN;
                qprev = *(const u32x4*)(zp - (c0 > 0 ? NIN : 0));
#pragma unroll
                for (int i = 0; i < 16; ++i) qq[i] = *(const u32x4*)(zp + (size_t)i * NIN); }
#pragma unroll 1
            for (int c = pw; c < NC + NBUF; c += NBUF) {
                if (c >= NBUF) {
                    { const unsigned want = (unsigned)(c - NBUF + 1); lds_wait_ge(ctr + 4, want); lds_wait_ge(ctr + 5, want); lds_wait_ge(ctr + 6, want); lds_wait_ge(ctr + 7, want); }
#pragma unroll 1
                    for (int it = 0; it < 4; ++it) {
                        const int etl = 4 * it + (lane >> 4), o = etl * 64 + 4 * ecg;
                        const f32x4 y = *(const LAS f32x4*)((LAS float*)(bb + B_Y) + o), v = *(const LAS f32x4*)(opV + etl * RS + 4 * ecg), g = *(const LAS f32x4*)(gV + o);
                        const float mean = rowsum16((y[0] + y[1]) + (y[2] + y[3])) * (1.0f / 64.0f);
                        const f32x4 d = y - mean;
                        const float var = rowsum16((d[0] * d[0] + d[1] * d[1]) + (d[2] * d[2] + d[3] * d[3])) * (1.0f / 64.0f);
                        const f32x4 ov = (d * (1.0f / sqrtf(var + 64e-5f)) * c_lg + c_lb + ((LAS float*)(bb + B_BON))[etl] * v) * g;
                        u32x2 w; w.x = pg8::cvt_pk_bf16(ov[0], ov[1]); w.y = pg8::cvt_pk_bf16(ov[2], ov[3]);
                        *(u32x2*)(mixin + ((size_t)row0 + (c - NBUF) * TC + etl) * DM + 256 + h * 64 + 4 * ecg) = w;
                    }
                    LDS_FENCE();
                }
                if (c < NC) {
                const bf16_t* lp = lora_a + ((size_t)row0 + (size_t)c * TC + fr) * 256 + fq * 8;
                const bf16x8 xw0 = *(const bf16x8*)(lp), xw1 = *(const bf16x8*)(lp + 32), xl0 = *(const bf16x8*)(lp + 64), xl1 = *(const bf16x8*)(lp + 96);
                const bf16x8 xg0 = *(const bf16x8*)(lp + 128), xg1 = *(const bf16x8*)(lp + 160), xg2 = *(const bf16x8*)(lp + 192), xg3 = *(const bf16x8*)(lp + 224);
                if (act1) {
                    float prv[8];
                    if (c > 0) { const u32x4 q = qprev;
                        prv[0] = bf_lo(q.x); prv[1] = bf_hi(q.x); prv[2] = bf_lo(q.y); prv[3] = bf_hi(q.y); prv[4] = bf_lo(q.z); prv[5] = bf_hi(q.z); prv[6] = bf_lo(q.w); prv[7] = bf_hi(q.w); }
                    else { prv[0] = pv0[0]; prv[1] = pv0[1]; prv[2] = pv0[2]; prv[3] = pv0[3]; prv[4] = pv1[0]; prv[5] = pv1[1]; prv[6] = pv1[2]; prv[7] = pv1[3]; }
                    LAS float* dst0 = (cc < 8 ? opR : (cc < 16 ? opK : opV)) + (cc & 7) * 8;
#pragma unroll
                    for (int i = 0; i < 16; ++i) {
                        const u32x4 q = qq[i];
                        float cur[8] = {bf_lo(q.x), bf_hi(q.x), bf_lo(q.y), bf_hi(q.y), bf_lo(q.z), bf_hi(q.z), bf_lo(q.w), bf_hi(q.w)};
                        float zs[8];
#pragma unroll
                        for (int j = 0; j < 8; ++j) { zs[j] = cur[j] + (prv[j] - cur[j]) * (j < 4 ? m0[j] : m1[j - 4]); prv[j] = cur[j]; }
                        *(LAS f32x4*)(dst0 + i * RS) = (f32x4){zs[0], zs[1], zs[2], zs[3]}; *(LAS f32x4*)(dst0 + i * RS + 4) = (f32x4){zs[4], zs[5], zs[6], zs[7]};
                    }
                }
                { const int cn = (c + NBUF < NC) ? c + NBUF : NC - 1; const bf16_t* zp = zbase + (size_t)(cn * TC) * NIN;
                    qprev = *(const u32x4*)(zp - (cn > 0 ? NIN : 0));
#pragma unroll
                    for (int i = 0; i < 16; ++i) qq[i] = *(const u32x4*)(zp + (size_t)i * NIN); }
                LDS_FENCE();
#pragma unroll 1
                for (int nt = 0; nt < 4; ++nt) {
                    f32x4 dw = {0.f, 0.f, 0.f, 0.f}, da = dw, dg = dw;
                    { const LAS bf16_t* wp = w2t + (nt * 16 + fr) * XS + fq * 8; const LAS bf16_t* ap = a2t + (nt * 16 + fr) * XS + fq * 8; const LAS bf16_t* gp = g2t + (nt * 16 + fr) * XGS + fq * 8;
                        dw = __builtin_amdgcn_mfma_f32_16x16x32_bf16(xw0, *(const LAS bf16x8*)wp, dw, 0, 0, 0); dw = __builtin_amdgcn_mfma_f32_16x16x32_bf16(xw1, *(const LAS bf16x8*)(wp + 32), dw, 0, 0, 0);
                        da = __builtin_amdgcn_mfma_f32_16x16x32_bf16(xl0, *(const LAS bf16x8*)ap, da, 0, 0, 0); da = __builtin_amdgcn_mfma_f32_16x16x32_bf16(xl1, *(const LAS bf16x8*)(ap + 32), da, 0, 0, 0);
                        dg = __builtin_amdgcn_mfma_f32_16x16x32_bf16(xg0, *(const LAS bf16x8*)gp, dg, 0, 0, 0); dg = __builtin_amdgcn_mfma_f32_16x16x32_bf16(xg1, *(const LAS bf16x8*)(gp + 32), dg, 0, 0, 0);
                        dg = __builtin_amdgcn_mfma_f32_16x16x32_bf16(xg2, *(const LAS bf16x8*)(gp + 64), dg, 0, 0, 0); dg = __builtin_amdgcn_mfma_f32_16x16x32_bf16(xg3, *(const LAS bf16x8*)(gp + 96), dg, 0, 0, 0); }
                    const float w0n = nt == 0 ? cw0[0] : nt == 1 ? cw0[1] : nt == 2 ? cw0[2] : cw0[3], a0n = nt == 0 ? ca0[0] : nt == 1 ? ca0[1] : nt == 2 ? ca0[2] : ca0[3];
                    f32x4 e, E = {0.f, 0.f, 0.f, 0.f};
#pragma unroll
                    for (int j = 0; j < 4; ++j) e[j] = -0.8750402888f * fsig(w0n + dw[j]);
#pragma unroll
                    for (int j = 0; j < 4; ++j) E = MFMA4((4 * fq + j <= fr) ? 1.0f : 0.0f, e[j], E);
#pragma unroll
                    for (int j = 0; j < 4; ++j) { const int t = 4 * fq + j, n = nt * 16 + fr;
                        const float P = __builtin_amdgcn_exp2f(E[j]);
                        opB[t * RS + n] = P; opA[t * RS + n] = __builtin_amdgcn_exp2f(E[j] - e[j]);
                        if (t == 15) ((LAS float*)(bb + B_PC))[n] = P;
                        aL[t * 64 + n] = fsig(a0n + da[j]); gV[t * 64 + n] = dg[j]; }
                }
                LDS_FENCE();
#pragma unroll 1
                for (int it = 0; it < 4; ++it) {
                    const int etl = 4 * it + (lane >> 4), o = etl * RS + 4 * ecg;
                    const f32x4 kr = *(const LAS f32x4*)(opK + o), a = *(const LAS f32x4*)(aL + etl * 64 + 4 * ecg), r = *(const LAS f32x4*)(opR + o);
                    const f32x4 P = *(const LAS f32x4*)(opB + o), Pex = *(const LAS f32x4*)(opA + o);
                    f32x4 kk = kr * c_kk;
                    const float nn = rowsum16((kk[0] * kk[0] + kk[1] * kk[1]) + (kk[2] * kk[2] + kk[3] * kk[3]));
                    kk = kk * (1.0f / fmaxf(sqrtf(nn), 1e-12f));
                    const f32x4 kp = kr * (1.0f + (a - 1.0f) * c_ka);
                    f32x4 inv;
#pragma unroll
                    for (int j = 0; j < 4; ++j) inv[j] = __builtin_amdgcn_rcpf(P[j]);
                    *(LAS f32x4*)(opK + o) = kp * inv; *(LAS f32x4*)(opA + o) = -kk * Pex; *(LAS f32x4*)(opB + o) = kk * a * inv; *(LAS f32x4*)(opR + o) = r * P;
                    const f32x4 rb = r * kp * c_rk;
                    const float bs = rowsum16((rb[0] + rb[1]) + (rb[2] + rb[3]));
                    if (ecg == 0) ((LAS float*)(bb + B_BON))[etl] = bs;
                }
                LDS_FENCE();
                LDS_FENCE();
                if (lane == 0) __hip_atomic_store(ctr + pw, (unsigned)(c + 1), __ATOMIC_RELEASE, __HIP_MEMORY_SCOPE_WORKGROUP);
                }
            }
            __builtin_amdgcn_s_setprio(0);
        }
#undef LDS_FENCE
    }
    __syncthreads();
}
#undef MFMA4

#define XB_TMO      128
#define XB_XCNT(j)  (256  + 64 * (j))
#define XB_XSUB(j)  (1280 + 64 * (j))
#define XB_XGEN(j)  (2304 + 64 * (j))
#define XB_TOP      3328
#define XB_TOPGEN   3392
#define XCD_BAR_WORDS 3456
#define XB_SPIN_CAP (1u << 18)

__device__ __forceinline__ unsigned xb_ld(unsigned* p)              { return __hip_atomic_load(p, __ATOMIC_RELAXED, __HIP_MEMORY_SCOPE_AGENT); }
__device__ __forceinline__ unsigned xb_add(unsigned* p, unsigned v) { return __hip_atomic_fetch_add(p, v, __ATOMIC_RELAXED, __HIP_MEMORY_SCOPE_AGENT); }
__device__ __forceinline__ unsigned xb_xcc_id() { return (unsigned)__builtin_amdgcn_s_getreg((3 << 11) | 20) & 0xFu; }
#define XB_SPIN(cond, bar) do { unsigned _sp = 0; while (cond) { __builtin_amdgcn_s_sleep(1); \
    if ((++_sp & 255u) == 0u) { if (xb_ld(&(bar)[XB_TMO])) break; if (_sp > XB_SPIN_CAP) { atomicAdd(&(bar)[XB_TMO], 1u); break; } } } } while (0)

struct XcdBarrier {
    unsigned* bar; unsigned x;
    volatile LAS unsigned* st;
};

__device__ __forceinline__ XcdBarrier xcd_barrier_post(unsigned* bar, volatile LAS unsigned* st) {
    XcdBarrier b; b.bar = bar; b.x = xb_xcc_id(); b.st = st;
    if (threadIdx.x == 0) (void)xb_add(&bar[XB_XCNT(b.x)], 1u);
    return b;
}
__device__ __forceinline__ void xcd_barrier_complete(unsigned* bar, unsigned x, unsigned& nloc, unsigned& nx) {
    const unsigned G = gridDim.x * gridDim.y * gridDim.z;
    unsigned sum, cnt, mine, sp = 0u;
    for (;;) {
        sum = 0u; cnt = 0u; mine = 0u;
#pragma unroll
        for (unsigned j = 0; j < 16; ++j) { const unsigned c = xb_ld(&bar[XB_XCNT(j)]); sum += c; cnt += (c > 0u) ? 1u : 0u; mine = (j == x) ? c : mine; }
        if (sum == G) break;
        __builtin_amdgcn_s_sleep(1);
        if ((++sp & 255u) == 0u) { if (xb_ld(&bar[XB_TMO])) break; if (sp > XB_SPIN_CAP) { atomicAdd(&bar[XB_TMO], 1u); break; } }
    }
    nloc = mine > 0u ? mine : 1u; nx = cnt > 0u ? cnt : 1u;
}

__device__ __forceinline__ void xcd_barrier(const XcdBarrier& b) {
    asm volatile("s_waitcnt vmcnt(0)" ::: "memory");
    __syncthreads();
    if (threadIdx.x == 0) {
        unsigned* bar = b.bar;
        __builtin_amdgcn_s_waitcnt(0);
        unsigned nloc = b.st[0], nx = b.st[1];
        if (nloc == 0u) { xcd_barrier_complete(bar, b.x, nloc, nx); b.st[0] = nloc; b.st[1] = nx; }
        const unsigned old = xb_add(&bar[XB_XSUB(b.x)], 1u);
        const unsigned gen = old / nloc;
        if (old + 1u == (gen + 1u) * nloc) {
            __builtin_amdgcn_fence(__ATOMIC_RELEASE, "agent");
            asm volatile("s_waitcnt vmcnt(0)" ::: "memory");
            const unsigned og = xb_add(&bar[XB_TOP], 1u);
            const unsigned tg = og / nx;
            if (og + 1u == (tg + 1u) * nx) xb_add(&bar[XB_TOPGEN], 1u);
            else XB_SPIN(xb_ld(&bar[XB_TOPGEN]) == tg, bar);
            __builtin_amdgcn_fence(__ATOMIC_ACQUIRE, "agent");
            xb_add(&bar[XB_XGEN(b.x)], 1u);
            asm volatile("s_waitcnt vmcnt(0)" ::: "memory");
        } else {
            XB_SPIN(xb_ld(&bar[XB_XGEN(b.x)]) == gen, bar);
            __builtin_amdgcn_fence(__ATOMIC_ACQUIRE, "agent");
            asm volatile("s_waitcnt vmcnt(0)" ::: "memory");
        }
    }
    __syncthreads();
}

template <class Epi> __device__ __forceinline__ void run_gemm(LAS unsigned char* lds, const bf16_t* A, const bf16_t* Bt, int N, int K, const Epi E, int rot, int gsub = 0, int csub = 0) {
    asm volatile("" : "+s"(K), "+s"(N));
    pg8::Gemm g{A, Bt, MROWS, N, K}; pg8::StaticOrder S;
    if (gsub > 0) S.init(MROWS, N, gsub, csub);
    else S.init(MROWS, N, (int)gridDim.x, (int)((blockIdx.x + rot) % gridDim.x));
    pg8::gemm_phase<Epi, pg8::StaticOrder, false>((PG8_LAS unsigned char*)lds, g, S, E, nullptr);
}

template <class Epi> __device__ __forceinline__ void run_gemm_range(LAS unsigned char* lds, const bf16_t* A, const bf16_t* Bt, int N, int K, const Epi E, int i0, int i1) {
    asm volatile("" : "+s"(K), "+s"(N), "+s"(i0), "+s"(i1));
    pg8::Gemm g{A, Bt, MROWS, N, K}; pg8::RangeOrder S; S.init(MROWS, N, (int)gridDim.x, (int)blockIdx.x); S.i0 = i0; S.i1 = i1;
    pg8::gemm_phase<Epi, pg8::RangeOrder, false>((PG8_LAS unsigned char*)lds, g, S, E, nullptr);
}
#define COMMA ,
#define GEMM_THEN_LN(EPI_DECL, AOP, BOP, KK, LNG, LNB, XBO, OUTP, OUTS, STATSP) do { \
    if (gridDim.x == 256) { \
        _Pragma("unroll 1") for (int part = 0; part < 2; ++part) { \
            if (part == 0 || blockIdx.x < 8) { EPI_DECL; run_gemm_range(lds, AOP, BOP, DM, KK, E, part * 4, part ? 5 : 4); } \
            else ln_tiles(0, R, LNG, LNB, XBO, OUTP, OUTS, STATSP); \
            xcd_barrier(xbar); } \
        ln_tiles(1, R, LNG, LNB, XBO, OUTP, OUTS, STATSP); \
    } else { { EPI_DECL; run_gemm(lds, AOP, BOP, DM, KK, E, 0); } xcd_barrier(xbar); ln_phase(R, LNG, LNB, XBO, OUTP, OUTS, STATSP); } } while (0)
__global__ void __launch_bounds__(NTHREADS, 2) mega_fwd(Params p_unused) {
    extern __shared__ __attribute__((aligned(16))) unsigned char lds_raw[];
    LAS unsigned char* lds = (LAS unsigned char*)lds_raw;
    cg::grid_group grid = cg::this_grid();
    unsigned char* ws = fresh_params().ws;
    bf16_t* WT = (bf16_t*)(ws + OFF_WT); float* R = (float*)(ws + OFF_R); bf16_t* XB = (bf16_t*)(ws + OFF_XB); bf16_t* HZ = (bf16_t*)(ws + OFF_HZ);
    bf16_t* PB = (bf16_t*)(ws + OFF_PB); bf16_t* PPb = (bf16_t*)(ws + OFF_PP); bf16_t* POOLED = PPb; float* STATS = (float*)(ws + OFF_STATS); const float* GB = (const float*)(ws + OFF_GB);

    if (threadIdx.x < 4) ((LAS unsigned*)(lds + LDS_XB))[threadIdx.x] = 0u;
    __syncthreads();
    const XcdBarrier xbar = xcd_barrier_post((unsigned*)(ws + OFF_BAR), (volatile LAS unsigned*)(lds + LDS_XB));
    prologue(lds);
    grid.sync();
    for (int l = 0; l < 2; ++l) {
        const Params& p = fresh_params();
        const bf16_t* W = WT + (size_t)l * WT_LAYER;
        { pg8::EpiSwiglu E{HZ, DFF}; run_gemm(lds, XB, W + WT_FFN1IN, 2 * DFF, DM, E, 0); }
        xcd_barrier(xbar);
        if (l == 0) GEMM_THEN_LN(pg8::EpiResidIn E{p.in[0] COMMA p.in[1] - (size_t)MP * DM COMMA MP COMMA R COMMA ALPHA_F COMMA 0.5f}, HZ, W + WT_FFN1OUT, DFF, p.in[7] + l * DM, p.in[8] + l * DM, XB, nullptr, nullptr, STATS);
        else GEMM_THEN_LN(pg8::EpiResidLN<false COMMA true> E{R COMMA nullptr COMMA (int)(OFF_STATS - OFF_R) COMMA (int)(OFF_GB - OFF_R) + 2 * 8192}, HZ, W + WT_FFN1OUT, DFF, p.in[7] + l * DM, p.in[8] + l * DM, XB, nullptr, nullptr, STATS);
        xcd_barrier(xbar);
        { pg8::EpiStoreBf16 E{HZ, NIN, nullptr}; run_gemm(lds, XB, W + WT_WIN, NIN, DM, E, 0); }
        xcd_barrier(xbar);
        mixprep_phase(l, HZ, POOLED, POOLED + (size_t)MROWS * 256);
        xcd_barrier(xbar);
        if (gridDim.x == 256) { if (blockIdx.x >= 192) { pg8::EpiStoreBf16 E{XB, DM, p.in[20] + l * 256}; run_gemm(lds, POOLED, W + WT_POOL, 256, 256, E, 0, 64, (int)blockIdx.x - 192); } }
        else { pg8::EpiStoreBf16 E{XB, DM, p.in[20] + l * 256}; run_gemm(lds, POOLED, W + WT_POOL, 256, 256, E, 0); }
        scan_phase(l, HZ, POOLED + (size_t)MROWS * 256, XB, lds);
        xcd_barrier(xbar);
        GEMM_THEN_LN(pg8::EpiResidLN<false COMMA false> E{R COMMA nullptr COMMA (int)(OFF_STATS - OFF_R) COMMA (int)(OFF_GB - OFF_R) + (l * 3 + 0) * 8192}, XB, W + WT_WOUT, DM, p.in[9] + l * DM, p.in[10] + l * DM, XB, nullptr, nullptr, STATS);
        xcd_barrier(xbar);
        { pg8::EpiSwiglu E{HZ, DFF}; run_gemm(lds, XB, W + WT_FFN2IN, 2 * DFF, DM, E, 0); }
        xcd_barrier(xbar);
        { pg8::EpiResidLN<true, true> E{R, XB, (int)(OFF_STATS - OFF_R), (int)(OFF_GB - OFF_R) + (l * 3 + 1) * 8192}; run_gemm(lds, HZ, W + WT_FFN2OUT, DM, DFF, E, 0); }
        { pg8::EpiStoreBf16 E{PPb, DM, nullptr}; const bool sub = gridDim.x == 256;
          if (!sub || blockIdx.x >= 8) run_gemm(lds, PB + (size_t)l * MROWS * 256, W + WT_PLE, DM, 256, E, sub ? 0 : 128, sub ? 248 : 0, sub ? (int)blockIdx.x - 8 : 0); }
        xcd_barrier(xbar);
        GEMM_THEN_LN(pg8::EpiGate E{R COMMA PPb COMMA p.in[33] + l * DM COMMA DM}, XB, W + WT_GATE, DM, p.in[11] + l * DM, p.in[12] + l * DM, (l == 0 ? XB : (bf16_t*)nullptr), (l == 0 ? (float*)nullptr : p.out + O_YP), (l == 0 ? (float*)nullptr : p.out + O_YS), (l == 0 ? STATS : (float*)nullptr));
        if (l == 0) xcd_barrier(xbar);
    }
}

extern "C" void kernel_launch(void* const* d_in, const int* in_sizes, int n_in, void* d_out, int out_size, void* d_ws, size_t ws_size, hipStream_t stream) {
    static int grid_blocks = 0;
    if (grid_blocks == 0) {
        if (n_in != 35 || ws_size < WS_END) { fprintf(stderr, "kernel_launch: expected 35 inputs and >= %zu bytes of workspace, got %d and %zu\n", (size_t)WS_END, n_in, ws_size); grid_blocks = -1; return; }
        int dev = 0, cus = 0, per_cu = 0;
        hipGetDevice(&dev);
        hipDeviceGetAttribute(&cus, hipDeviceAttributeMultiprocessorCount, dev);
        if (hipFuncSetAttribute((const void*)mega_fwd, hipFuncAttributeMaxDynamicSharedMemorySize, LDS_BYTES) != hipSuccess) { fprintf(stderr, "kernel_launch: hipFuncSetAttribute failed\n"); (void)hipGetLastError(); }
        if (hipOccupancyMaxActiveBlocksPerMultiprocessor(&per_cu, (const void*)mega_fwd, NTHREADS, LDS_BYTES) != hipSuccess || per_cu < 1) { fprintf(stderr, "kernel_launch: occupancy query gave %d\n", per_cu); per_cu = 1; (void)hipGetLastError(); }
        grid_blocks = cus * per_cu;
    }
    if (grid_blocks < 0) return;
    Params p{};
    for (int i = 0; i < 35; ++i) p.in[i] = (const float*)d_in[i];
    p.out = (float*)d_out; p.ws = (unsigned char*)d_ws;
    (void)hipMemsetAsync((char*)d_ws + OFF_BAR, 0, 13824, stream);
    void* args[] = {&p};
    hipError_t e = hipLaunchCooperativeKernel((const void*)mega_fwd, dim3(grid_blocks), dim3(NTHREADS), args, LDS_BYTES, stream);
    if (e != hipSuccess) fprintf(stderr, "cooperative launch failed: %s (grid %d)\n", hipGetErrorString(e), grid_blocks);
}
```

```cpp
#include <hip/hip_runtime.h>
#include <hip/hip_cooperative_groups.h>
#include <cstdio>
namespace cg = cooperative_groups;
namespace pg8 {
#define PG8_LAS __attribute__((address_space(3)))
typedef unsigned short bf16_t;
typedef short bf16x8 __attribute__((ext_vector_type(8)));
typedef float f32x4 __attribute__((ext_vector_type(4)));
typedef unsigned u32x4 __attribute__((ext_vector_type(4)));
constexpr int BM = 256, BK = 64, HALF = 128, HTB = HALF * BK * 2  , STAGE_BYTES = 8 * HTB, NXCD = 8, WGM = 8;

__host__ __device__ __forceinline__ int lds_byte(int r, int c) { const int st = (r >> 4) * 2 + (c >> 5), rr = r & 15, cc = c & 31, ob = rr * 64 + cc * 2; return st * 1024 + (ob ^ (((ob >> 9) & 1) << 5)); }
__host__ __device__ __forceinline__ void stage_rc(int b, int& R, int& C) { const int st = b / 1024, sb = b % 1024, swz = sb ^ (((sb >> 9) & 1) << 5); R = (st >> 1) * 16 + swz / 64; C = (st & 1) * 32 + (swz % 64) / 2; }
__host__ __device__ __forceinline__ int perm32(int rho) { const int n = rho >> 4, i = rho & 15; return 8 * (i >> 2) + 4 * n + (i & 3); }

struct Unit { int pm, pn; };
struct Gemm { const bf16_t* A; const bf16_t* Bt; int M, N, K; };

struct StaticOrder {
    int nM, nN, nwg, G, c;
    __host__ __device__ void init(int M, int N, int G_, int c_) { nM = M / BM; nN = N / BM; nwg = nM * nN; G = G_; c = c_; }
    __host__ __device__ bool next(int i, Unit& u) const {
        const long L = (long)i * G + c; if (L >= nwg) return false;
        int wgid = (int)L; { const int q = nwg / NXCD, r = nwg % NXCD, xcd = wgid % NXCD, off = wgid / NXCD; wgid = (xcd < r ? xcd * (q + 1) : r * (q + 1) + (xcd - r) * q) + off; }
        const int nig = WGM * nN, gid = wgid / nig, fm = gid * WGM, gsz = (nM - fm) < WGM ? (nM - fm) : WGM;
        u.pm = fm + ((wgid % nig) % gsz); u.pn = (wgid % nig) / gsz; return true;
    }
    __device__ __forceinline__ void a_ready(const Unit&) const {}
    __device__ __forceinline__ void done(const Unit&) const {}
};
struct RangeOrder : StaticOrder { int i0, i1;
    __host__ __device__ bool next(int i, Unit& u) const { return (i + i0 < i1) && StaticOrder::next(i + i0, u); } };
__device__ __forceinline__ unsigned cvt_pk_bf16(float lo, float hi) { typedef float f2_ __attribute__((ext_vector_type(2))); typedef __bf16 b2_ __attribute__((ext_vector_type(2))); const f2_ v = {lo, hi}; return __builtin_bit_cast(unsigned, __builtin_convertvector(v, b2_)); }
typedef float f32x2 __attribute__((ext_vector_type(2)));
typedef unsigned u32x2 __attribute__((ext_vector_type(2)));
__device__ __forceinline__ float fast_sigmoid(float x) { return __builtin_amdgcn_rcpf(1.0f + __builtin_amdgcn_exp2f(-1.4426950408889634f * x)); }

struct EpiSwiglu {
    static constexpr bool PERM = true, AFTER_DRAIN = false;
    bf16_t* H; int ldh;
    __device__ __forceinline__ void operator()(const f32x4 (&acc)[2][2][4][2], const Unit& u, int wr, int wc, int fr, int fq) const {
        const int row0 = u.pm * BM + wr * 64 + fr, col0 = u.pn * HALF + wc * 32 + 8 * fq;
#pragma unroll
        for (int ai = 0; ai < 2; ++ai)
#pragma unroll
            for (int m = 0; m < 4; ++m) {
                bf16_t* rowp = H + (size_t)(row0 + ai * HALF + m * 16) * ldh + col0;
                float h[8];
#pragma unroll
                for (int n = 0; n < 2; ++n)
#pragma unroll
                    for (int j = 0; j < 4; ++j) { const float g = acc[ai][0][m][n][j], up = acc[ai][1][m][n][j]; h[n * 4 + j] = g * fast_sigmoid(g) * up; }
                u32x4 w; w.x = cvt_pk_bf16(h[0], h[1]); w.y = cvt_pk_bf16(h[2], h[3]); w.z = cvt_pk_bf16(h[4], h[5]); w.w = cvt_pk_bf16(h[6], h[7]);
                *(u32x4*)rowp = w;
            }
    }
};
struct EpiStoreBf16 {
    static constexpr bool PERM = true, AFTER_DRAIN = false;
    bf16_t* O; int ldc; const float* cscale;
    __device__ __forceinline__ void operator()(const f32x4 (&acc)[2][2][4][2], const Unit& u, int wr, int wc, int fr, int fq) const {
        const int row0 = u.pm * BM + wr * 64 + fr, col0 = u.pn * BM + wc * 32 + 8 * fq;
        f32x4 sc[2][2];
#pragma unroll
        for (int bj = 0; bj < 2; ++bj)
#pragma unroll
            for (int n = 0; n < 2; ++n) sc[bj][n] = cscale ? *(const f32x4*)(cscale + col0 + bj * HALF + 4 * n) : (f32x4){1.f, 1.f, 1.f, 1.f};
#pragma unroll
        for (int ai = 0; ai < 2; ++ai)
#pragma unroll
            for (int m = 0; m < 4; ++m) { bf16_t* rowp = O + (size_t)(row0 + ai * HALF + m * 16) * ldc + col0;
#pragma unroll
                for (int bj = 0; bj < 2; ++bj) { const f32x4 v0 = acc[ai][bj][m][0] * sc[bj][0], v1 = acc[ai][bj][m][1] * sc[bj][1];
                    u32x4 w; w.x = cvt_pk_bf16(v0[0], v0[1]); w.y = cvt_pk_bf16(v0[2], v0[3]); w.z = cvt_pk_bf16(v1[0], v1[1]); w.w = cvt_pk_bf16(v1[2], v1[3]);
                    *(u32x4*)(rowp + bj * HALF) = w; } }
    }
};
struct EpiResidIn {
    static constexpr bool PERM = false, AFTER_DRAIN = false;
    const float* srcA; const float* srcB; int split_row; float* out; float sa, sb;
    __device__ __forceinline__ void operator()(const f32x4 (&acc)[2][2][4][2], const Unit& u, int wr, int wc, int fr, int fq) const {
        constexpr int ldc = 1024;
        const int row0 = u.pm * BM + wr * 64 + fr, col0 = u.pn * BM + wc * 32 + 4 * fq;
        const float* src = (u.pm * BM >= split_row) ? srcB : srcA;
#pragma unroll
        for (int ai = 0; ai < 2; ++ai)
#pragma unroll
            for (int m = 0; m < 4; ++m) { const size_t off = (size_t)(row0 + ai * HALF + m * 16) * ldc + col0;
#pragma unroll
                for (int bj = 0; bj < 2; ++bj)
#pragma unroll
                    for (int n = 0; n < 2; ++n) { const f32x4 s = *(const f32x4*)(src + off + bj * HALF + n * 16); *(f32x4*)(out + off + bj * HALF + n * 16) = s * sa + acc[ai][bj][m][n] * sb; }
                asm volatile("" ::: "memory"); }
    }
};
template <bool OB, bool SBHALF> struct EpiResidLN {
    static constexpr bool PERM = false, AFTER_DRAIN = false;
    float* out; bf16_t* ob; int stats_off, gb_off;
    __device__ __forceinline__ void operator()(const f32x4 (&acc)[2][2][4][2], const Unit& u, int wr, int wc, int fr, int fq) const {
        constexpr int ldc = 1024;
        const int row0 = u.pm * BM + wr * 64 + fr, col0 = u.pn * BM + wc * 32 + 4 * fq;
        float* const out = this->out; bf16_t* const ob = this->ob; const float sa = 1.4142135623730951f, sb = SBHALF ? 0.5f : 1.0f;
        const float* const stats = (const float*)((const char*)out + stats_off); const float* const gb = (const float*)((const char*)out + gb_off);
#pragma unroll
        for (int bj = 0; bj < 2; ++bj)
#pragma unroll
            for (int n = 0; n < 2; ++n) {
                const int cc = col0 + bj * HALF + n * 16;
                const f32x4 gv = *(const f32x4*)(gb + cc), bv = *(const f32x4*)(gb + 1024 + cc);
#pragma unroll
                for (int ai = 0; ai < 2; ++ai)
#pragma unroll
                    for (int m = 0; m < 4; ++m) { const int row = row0 + ai * HALF + m * 16; const unsigned off = (unsigned)row * ldc + cc;
                        const f32x4 s0 = *(const f32x4*)(out + off); const f32x2 st = *(const f32x2*)(stats + 2u * (unsigned)row);
                        const f32x4 o = ((s0 - st.x) * st.y * gv + bv) * sa + acc[ai][bj][m][n] * sb;
                        *(f32x4*)(out + off) = o;
                        if (OB) { u32x2 w; w.x = cvt_pk_bf16(o[0], o[1]); w.y = cvt_pk_bf16(o[2], o[3]); *(u32x2*)(ob + off) = w; } }
                asm volatile("" ::: "memory"); }
    }
};
struct EpiGate {
    static constexpr bool PERM = false, AFTER_DRAIN = false;
    float* R; const bf16_t* PP; const float* bias; int ldc;
    __device__ __forceinline__ void operator()(const f32x4 (&acc)[2][2][4][2], const Unit& u, int wr, int wc, int fr, int fq) const {
        const int row0 = u.pm * BM + wr * 64 + fr, col0 = u.pn * BM + wc * 32 + 4 * fq;
        f32x4 bv[2][2];
#pragma unroll
        for (int bj = 0; bj < 2; ++bj)
#pragma unroll
            for (int n = 0; n < 2; ++n) bv[bj][n] = *(const f32x4*)(bias + col0 + bj * HALF + n * 16);
#pragma unroll
        for (int ai = 0; ai < 2; ++ai)
#pragma unroll
            for (int m = 0; m < 4; ++m) { const size_t off = (size_t)(row0 + ai * HALF + m * 16) * ldc + col0;
#pragma unroll
                for (int bj = 0; bj < 2; ++bj)
#pragma unroll
                    for (int n = 0; n < 2; ++n) { const size_t o2 = off + bj * HALF + n * 16; const f32x4 s = *(const f32x4*)(R + o2); const u32x2 pw = *(const u32x2*)(PP + o2);
                        const f32x4 a = acc[ai][bj][m][n] + bv[bj][n]; f32x4 o;
                        o[0] = s[0] + fast_sigmoid(a[0]) * __uint_as_float(pw.x << 16); o[1] = s[1] + fast_sigmoid(a[1]) * __uint_as_float(pw.x & 0xffff0000u);
                        o[2] = s[2] + fast_sigmoid(a[2]) * __uint_as_float(pw.y << 16); o[3] = s[3] + fast_sigmoid(a[3]) * __uint_as_float(pw.y & 0xffff0000u);
                        *(f32x4*)(R + o2) = o; }
                asm volatile("" ::: "memory"); }
    }
};
template <class Epi, class Sched, bool STAMP = false>
__device__ __forceinline__ void gemm_phase(PG8_LAS unsigned char* lds, const Gemm g, const Sched& S, const Epi& E, unsigned long long* stamps) {
    int tid_l = threadIdx.x; asm volatile("" : "+v"(tid_l));
    const int tid = tid_l, wid = __builtin_amdgcn_readfirstlane(tid >> 6), lane = tid & 63, wr = wid >> 2, wc = wid & 3, fr = lane & 15, fq = lane >> 4;
    const int K = g.K, nt = K / BK;
    int ts_lo = 0, ts_hi = 0, nts = 0; const unsigned long long rt_entry = STAMP ? (unsigned long long)wall_clock64() : 0ull;
#define PG8_STAMP() do { if (STAMP && wid == 0 && nts < 64) { const unsigned long long _c = (unsigned long long)clock64(); \
        ts_lo = (lane == nts) ? (int)(unsigned)_c : ts_lo; ts_hi = (lane == nts) ? (int)(unsigned)(_c >> 32) : ts_hi; ++nts; } } while (0)
    PG8_STAMP();
    unsigned voffA[2], voffB[2];
#pragma unroll
    for (int i = 0; i < 2; ++i) { int R, C; stage_rc(tid * 16 + i * 8192, R, C); const int Rb = Epi::PERM ? ((R & ~31) + perm32(R & 31)) : R;
        voffA[i] = (unsigned)(R * K + C) * 2u; voffB[i] = (unsigned)(Rb * K + C) * 2u; }
    const size_t kstep = (size_t)(BK * 2);
    const size_t hstep = (size_t)HALF * K * 2;
    const size_t tstep = 2 * hstep;
    const unsigned ldsw = (unsigned)wid * 1024u;
    const int aoff = lds_byte(wr * 64 + fr, fq * 8), boff = lds_byte(wc * 32 + fr, fq * 8);
#define PG8_SA(b, h) (((b) * 2 + (h)) * HTB)
#define PG8_SB(b, h) ((4 + (b) * 2 + (h)) * HTB)
#define PG8_STAGE(bufoff, gbase, voff) do { _Pragma("unroll") for (int _i = 0; _i < 2; ++_i) \
        __builtin_amdgcn_global_load_lds((const unsigned*)((const char*)(gbase) + (voff)[_i]), (PG8_LAS unsigned*)(lds + (bufoff) + ldsw + _i * 8192), 16, 0, 0); } while (0)
#define PG8_LDA(dst, b, h) do { _Pragma("unroll") for (int m = 0; m < 4; ++m) _Pragma("unroll") for (int k = 0; k < 2; ++k) dst[m][k] = *(const PG8_LAS bf16x8*)(lds + PG8_SA(b, h) + aoff + m * 2048 + k * 1024); } while (0)
#define PG8_LDB(dst, b, h) do { _Pragma("unroll") for (int n = 0; n < 2; ++n) _Pragma("unroll") for (int k = 0; k < 2; ++k) dst[n][k] = *(const PG8_LAS bf16x8*)(lds + PG8_SB(b, h) + boff + n * 2048 + k * 1024); } while (0)
#define PG8_MMA(ai, bj, At, Bt) do { __builtin_amdgcn_s_setprio(1); _Pragma("unroll") for (int m = 0; m < 4; ++m) _Pragma("unroll") for (int n = 0; n < 2; ++n) _Pragma("unroll") for (int k = 0; k < 2; ++k) \
        acc[ai][bj][m][n] = __builtin_amdgcn_mfma_f32_16x16x32_bf16(Bt[n][k], At[m][k], acc[ai][bj][m][n], 0, 0, 0); __builtin_amdgcn_s_setprio(0); } while (0)
#define PG8_WAIT_V(n) asm volatile("s_waitcnt vmcnt(" #n ")" ::: "memory")
#define PG8_WAIT_L(n) asm volatile("s_waitcnt lgkmcnt(" #n ")" ::: "memory")
#define PG8_BAR __builtin_amdgcn_s_barrier()
#define PG8_SCHED __builtin_amdgcn_sched_barrier(0)
    Unit cur, nxt; int ui = 0;
    if (!S.next(0, cur)) return;
    f32x4 acc[2][2][4][2];
#pragma unroll
    for (int a = 0; a < 2; ++a)
#pragma unroll
        for (int b = 0; b < 2; ++b)
#pragma unroll
            for (int m = 0; m < 4; ++m)
#pragma unroll
                for (int n = 0; n < 2; ++n) acc[a][b][m][n] = (f32x4){0.f, 0.f, 0.f, 0.f};
    bf16x8 At[4][2], B0[2][2], B1[2][2];
    const char* cA = (const char*)g.A + (size_t)cur.pm * tstep; const char* cB = (const char*)g.Bt + (size_t)cur.pn * tstep;
    S.a_ready(cur);
    PG8_STAGE(PG8_SB(0, 0), cB, voffB); PG8_STAGE(PG8_SA(0, 0), cA, voffA); PG8_STAGE(PG8_SB(0, 1), cB + hstep, voffB); PG8_STAGE(PG8_SA(0, 1), cA + hstep, voffA);
    if (wr == 1) PG8_BAR;
    PG8_WAIT_V(4); PG8_BAR;
    PG8_STAGE(PG8_SB(1, 0), cB + kstep, voffB); PG8_STAGE(PG8_SA(1, 0), cA + kstep, voffA); PG8_STAGE(PG8_SB(1, 1), cB + hstep + kstep, voffB);
    PG8_WAIT_V(6); PG8_BAR;
    PG8_STAMP();
    for (;;) {
        const bool has_next = S.next(ui + 1, nxt);
        const char* nA = has_next ? (const char*)g.A + (size_t)nxt.pm * tstep : cA; const char* nB = has_next ? (const char*)g.Bt + (size_t)nxt.pn * tstep : cB;
        for (int t = 0; t < nt; t += 2) {
            const bool last = (t == nt - 2);
            const char* a1 = cA + (size_t)(t + 1) * kstep;
            const char* a2 = last ? nA : cA + (size_t)(t + 2) * kstep; const char* b2 = last ? nB : cB + (size_t)(t + 2) * kstep;
            const char* a3 = a2 + kstep; const char* b3 = b2 + kstep;
            if (last && has_next) S.a_ready(nxt);
            PG8_LDB(B0, 0, 0); PG8_SCHED; PG8_LDA(At, 0, 0); PG8_STAGE(PG8_SA(1, 1), a1 + hstep, voffA);
            PG8_WAIT_L(8); PG8_BAR; PG8_WAIT_L(0); PG8_MMA(0, 0, At, B0); PG8_BAR; PG8_SCHED;
            PG8_LDB(B1, 0, 1); PG8_STAGE(PG8_SB(0, 0), b2, voffB);
            PG8_BAR; PG8_WAIT_L(0); PG8_MMA(0, 1, At, B1); PG8_BAR;
            PG8_LDA(At, 0, 1); PG8_STAGE(PG8_SA(0, 0), a2, voffA);
            PG8_BAR; PG8_WAIT_L(0); PG8_MMA(1, 0, At, B0); PG8_BAR; PG8_SCHED;
            PG8_STAGE(PG8_SB(0, 1), b2 + hstep, voffB);
            PG8_WAIT_V(6); PG8_BAR; PG8_MMA(1, 1, At, B1); PG8_BAR;
            PG8_LDB(B0, 1, 0); PG8_SCHED; PG8_LDA(At, 1, 0); PG8_STAGE(PG8_SA(0, 1), a2 + hstep, voffA);
            PG8_WAIT_L(8); PG8_BAR; PG8_WAIT_L(0); PG8_MMA(0, 0, At, B0); PG8_BAR; PG8_SCHED;
            PG8_LDB(B1, 1, 1); PG8_STAGE(PG8_SB(1, 0), b3, voffB);
            PG8_BAR; PG8_WAIT_L(0); PG8_MMA(0, 1, At, B1); PG8_BAR;
            PG8_LDA(At, 1, 1); PG8_STAGE(PG8_SA(1, 0), a3, voffA);
            PG8_BAR; PG8_WAIT_L(0); PG8_MMA(1, 0, At, B0); PG8_BAR; PG8_SCHED;
            PG8_STAGE(PG8_SB(1, 1), b3 + hstep, voffB);
            PG8_WAIT_V(6); PG8_BAR; PG8_MMA(1, 1, At, B1); PG8_BAR;
        }
        PG8_STAMP();
        if constexpr (!Epi::AFTER_DRAIN) { E(acc, cur, wr, wc, fr, fq); S.done(cur); }
        PG8_STAMP();
        if (!has_next) break;
#pragma unroll
        for (int a = 0; a < 2; ++a)
#pragma unroll
            for (int b = 0; b < 2; ++b)
#pragma unroll
                for (int m = 0; m < 4; ++m)
#pragma unroll
                    for (int n = 0; n < 2; ++n) acc[a][b][m][n] = (f32x4){0.f, 0.f, 0.f, 0.f};
        cur = nxt; cA = nA; cB = nB; ++ui;
    }
    PG8_WAIT_V(0);
    if (wr == 0) PG8_BAR;
    PG8_BAR;
    if constexpr (Epi::AFTER_DRAIN) { E.fused(acc, cur, wr, wc, fr, fq, lds, wid, lane); S.done(cur); }
    PG8_STAMP();
    if (STAMP && wid == 0) { stamps[lane] = lane < nts ? (((unsigned long long)(unsigned)ts_hi << 32) | (unsigned)ts_lo) : 0ull;
        if (lane == 62) stamps[62] = rt_entry; if (lane == 63) stamps[63] = (unsigned long long)wall_clock64(); }
#undef PG8_STAMP
#undef PG8_SA
#undef PG8_SB
#undef PG8_STAGE
#undef PG8_LDA
#undef PG8_LDB
#undef PG8_MMA
#undef PG8_WAIT_V
#undef PG8_WAIT_L
#undef PG8_BAR
#undef PG8_SCHED
}
}

#define LAS __attribute__((address_space(3)))
typedef unsigned short bf16_t;
typedef short bf16x8 __attribute__((ext_vector_type(8)));
typedef float f32x4 __attribute__((ext_vector_type(4)));
typedef unsigned u32x4 __attribute__((ext_vector_type(4)));
typedef unsigned u32x2 __attribute__((ext_vector_type(2)));
typedef float f32x2s __attribute__((ext_vector_type(2)));

constexpr int MROWS = 66048, MP = 65536, DM = 1024, DFF = 2816, NIN = 2816, NHEAD = 12;
constexpr float ALPHA_F = 1.4142135623730951f;
constexpr int LDS_XB = 156992;
constexpr int LDS_BYTES = 157056;
constexpr int NTHREADS = 512;
constexpr size_t WT_FFN1IN = 0, WT_FFN1OUT = 5767168, WT_WIN = 8650752, WT_POOL = 11534336, WT_WOUT = 11599872, WT_FFN2IN = 12648448, WT_FFN2OUT = 18415616,
                 WT_GATE = 21299200, WT_PLE = 22347776, WT_LAYER = 22609920;
constexpr size_t OFF_WT = 0, OFF_R = 90439680, OFF_XB = 360972288, OFF_HZ = 496238592, OFF_PB = 868220928, OFF_PP = 935854080, OFF_STATS = 1071120384, OFF_GB = 1071648768, OFF_BAR = 1071697920, WS_END = 1071711744;
constexpr size_t O_YP = 0, O_YS = 67108864, O_PP = 67633152, O_SP = 67756032, O_WP = 67837952, O_PS = 69410816, O_SS = 69533696, O_WS = 69615616;

struct Params { const float* in[35]; float* out; unsigned char* ws; };

__device__ __forceinline__ float bf_lo(unsigned w) { return __uint_as_float(w << 16); }
__device__ __forceinline__ float bf_hi(unsigned w) { return __uint_as_float(w & 0xffff0000u); }
__device__ __forceinline__ unsigned short f2bf(float f) { return (unsigned short)(pg8::cvt_pk_bf16(f, 0.f) & 0xffffu); }
__device__ __forceinline__ float wave_sum(float v) {
#pragma unroll
    for (int o = 32; o >= 1; o >>= 1) v += __shfl_xor(v, o);
    return v;
}
__device__ __forceinline__ const Params& fresh_params() { auto k = __builtin_amdgcn_kernarg_segment_ptr(); asm volatile("" : "+s"(k)); return *(const Params*)k; }
__device__ __forceinline__ int fresh_tid() { int t = threadIdx.x; asm volatile("" : "+v"(t)); return t; }
template <int CTRL> __device__ __forceinline__ float dpp_mov(float v) { return __builtin_bit_cast(float, __builtin_amdgcn_update_dpp(0, __builtin_bit_cast(int, v), CTRL, 0xF, 0xF, true)); }
__device__ __forceinline__ float allreduce8(float v) { v += dpp_mov<0xB1>(v); v += dpp_mov<0x4E>(v); v += dpp_mov<0x141>(v); return v; }
__device__ __forceinline__ float fsig(float x) { return __builtin_amdgcn_rcpf(1.0f + __builtin_amdgcn_exp2f(-1.4426950408889634f * x)); }
__device__ __forceinline__ float ftanh(float x) { return 1.0f - 2.0f * __builtin_amdgcn_rcpf(1.0f + __builtin_amdgcn_exp2f(2.8853900817779268f * x)); }

__device__ void convert_weight(const float* src, int K, int Nsrc, int Nd, int mode, bf16_t* dst, LAS float* tile) {
    const int tid = fresh_tid(), ntn = Nd / 64, ntk = K / 64;
    for (int t = blockIdx.x; t < ntn * ntk; t += gridDim.x) {
        const int tn = t % ntn, tk = t / ntn, n0 = tn * 64, k0 = tk * 64;
        int c0 = n0;
        if (mode == 1) { const int pn = n0 >> 8, w = n0 & 255; c0 = (w < 128) ? (128 * pn + w) : (DFF + 128 * pn + (w - 128)); }
#pragma unroll
        for (int i = 0; i < 2; ++i) { const int kk = (tid >> 4) + 32 * i, c4 = tid & 15;
            const f32x4 v = *(const f32x4*)(src + (size_t)(k0 + kk) * Nsrc + c0 + 4 * c4);
            tile[kk * 65 + 4 * c4 + 0] = v[0]; tile[kk * 65 + 4 * c4 + 1] = v[1]; tile[kk * 65 + 4 * c4 + 2] = v[2]; tile[kk * 65 + 4 * c4 + 3] = v[3]; }
        __syncthreads();
        { const int n = tid >> 3, k8 = tid & 7; float f[8];
#pragma unroll
            for (int j = 0; j < 8; ++j) f[j] = tile[(k8 * 8 + j) * 65 + n];
            u32x4 w; w.x = pg8::cvt_pk_bf16(f[0], f[1]); w.y = pg8::cvt_pk_bf16(f[2], f[3]); w.z = pg8::cvt_pk_bf16(f[4], f[5]); w.w = pg8::cvt_pk_bf16(f[6], f[7]);
            *(u32x4*)(dst + (size_t)(n0 + n) * K + k0 + k8 * 8) = w; }
        __syncthreads();
    }
}
__device__ void prologue(LAS unsigned char* lds) {
    const Params& p = fresh_params();
    LAS float* tile = (LAS float*)lds;
    bf16_t* WT = (bf16_t*)(p.ws + OFF_WT);
    for (int l = 0; l < 2; ++l) {
        bf16_t* W = WT + (size_t)l * WT_LAYER;
        convert_weight(p.in[13] + (size_t)l * DM * 2 * DFF, DM, 2 * DFF, 2 * DFF, 1, W + WT_FFN1IN, tile);
        convert_weight(p.in[14] + (size_t)l * DFF * DM, DFF, DM, DM, 0, W + WT_FFN1OUT, tile);
        convert_weight(p.in[17] + (size_t)l * DM * NIN, DM, NIN, NIN, 0, W + WT_WIN, tile);
        convert_weight(p.in[31] + (size_t)l * DM * DM, DM, DM, DM, 0, W + WT_WOUT, tile);
        convert_weight(p.in[15] + (size_t)l * DM * 2 * DFF, DM, 2 * DFF, 2 * DFF, 1, W + WT_FFN2IN, tile);
        convert_weight(p.in[16] + (size_t)l * DFF * DM, DFF, DM, DM, 0, W + WT_FFN2OUT, tile);
        convert_weight(p.in[32] + (size_t)l * DM * DM, DM, DM, DM, 0, W + WT_GATE, tile);
        convert_weight(p.in[34] + (size_t)l * 256 * DM, 256, DM, DM, 0, W + WT_PLE, tile);
        const float* pw = p.in[19] + (size_t)l * 4 * 64 * 64;
        for (int i = blockIdx.x * NTHREADS + fresh_tid(); i < 256 * 256; i += gridDim.x * NTHREADS) {
            const int n = i >> 8, k = i & 255, g = n >> 6, d = n & 63, g2 = k >> 6, c = k & 63;
            W[WT_POOL + i] = (g == g2) ? f2bf(pw[(g * 64 + c) * 64 + d]) : (bf16_t)0;
        }
    }
    { float* GBw = (float*)(p.ws + OFF_GB);
      for (int i = blockIdx.x * NTHREADS + fresh_tid(); i < 2 * 3 * 2048; i += gridDim.x * NTHREADS) {
          const int l = i / 6144, j = (i % 6144) / 2048, e = i % 2048;
          GBw[i] = p.in[7 + 2 * j + (e >> 10)][l * DM + (e & 1023)]; } }
    bf16_t* XB = (bf16_t*)(p.ws + OFF_XB);
    const size_t gt = (size_t)blockIdx.x * NTHREADS + fresh_tid(), gs = (size_t)gridDim.x * NTHREADS;
    for (size_t i = gt; i < (size_t)MROWS * DM / 8; i += gs) {
        const size_t e = i * 8; const float* s = (e < (size_t)MP * DM) ? p.in[0] + e : p.in[1] + (e - (size_t)MP * DM);
        const f32x4 a = *(const f32x4*)s, b = *(const f32x4*)(s + 4);
        u32x4 w; w.x = pg8::cvt_pk_bf16(a[0], a[1]); w.y = pg8::cvt_pk_bf16(a[2], a[3]); w.z = pg8::cvt_pk_bf16(b[0], b[1]); w.w = pg8::cvt_pk_bf16(b[2], b[3]);
        *(u32x4*)(XB + e) = w;
    }
    bf16_t* PB = (bf16_t*)(p.ws + OFF_PB);
    for (size_t i = gt; i < (size_t)2 * MROWS * 256 / 8; i += gs) {
        const size_t e = i * 8; const int l = (int)(e / ((size_t)MROWS * 256)); const size_t r = e - (size_t)l * MROWS * 256;
        const float* s = (r < (size_t)MP * 256) ? p.in[2] + (size_t)l * MP * 256 + r : p.in[3] + (size_t)l * 512 * 256 + (r - (size_t)MP * 256);
        const f32x4 a = *(const f32x4*)s, b = *(const f32x4*)(s + 4);
        u32x4 w; w.x = pg8::cvt_pk_bf16(a[0], a[1]); w.y = pg8::cvt_pk_bf16(a[2], a[3]); w.z = pg8::cvt_pk_bf16(b[0], b[1]); w.w = pg8::cvt_pk_bf16(b[2], b[3]);
        *(u32x4*)(PB + e) = w;
    }
}

__device__ __forceinline__ void ln_row(int row, int lane, float* R, const f32x4 (&gv)[4], const f32x4 (&bv)[4], bf16_t* xb, float* outp, float* outs, float* stats) {
    float* rp = R + (size_t)row * DM;
    f32x4 v[4]; float s = 0.f;
#pragma unroll
    for (int i = 0; i < 4; ++i) { v[i] = *(const f32x4*)(rp + i * 256 + lane * 4); s += (v[i][0] + v[i][1]) + (v[i][2] + v[i][3]); }
    const float mean = wave_sum(s) * (1.0f / 1024.0f);
    float q = 0.f;
#pragma unroll
    for (int i = 0; i < 4; ++i) { v[i] = v[i] - mean; q += (v[i][0] * v[i][0] + v[i][1] * v[i][1]) + (v[i][2] * v[i][2] + v[i][3] * v[i][3]); }
    const float rstd = 1.0f / sqrtf(wave_sum(q) * (1.0f / 1024.0f) + 1e-5f);
    float* op = outp ? ((row < MP) ? outp + (size_t)row * DM : outs + (size_t)(row - MP) * DM) : rp;
    if (stats && lane == 0) *(f32x2s*)(stats + 2 * (size_t)row) = (f32x2s){mean, rstd};
#pragma unroll
    for (int i = 0; i < 4; ++i) { const f32x4 y = v[i] * rstd * gv[i] + bv[i];
        if (!stats) *(f32x4*)(op + i * 256 + lane * 4) = y;
        if (xb) { u32x2 w; w.x = pg8::cvt_pk_bf16(y[0], y[1]); w.y = pg8::cvt_pk_bf16(y[2], y[3]); *(u32x2*)(xb + (size_t)row * DM + i * 256 + lane * 4) = w; } }
}
__device__ void ln_tiles(int part, float* R, const float* g, const float* b, bf16_t* xb, float* outp, float* outs, float* stats) {
    const int tid = fresh_tid(), lane = tid & 63, wave = tid >> 6;
    int s0, s1, s2, s3, s4, s5, s6, s7;
    { pg8::StaticOrder S8; pg8::Unit u8;
      S8.init(MROWS, DM, 256, 0); S8.next(4, u8); s0 = u8.pm; S8.init(MROWS, DM, 256, 1); S8.next(4, u8); s1 = u8.pm; S8.init(MROWS, DM, 256, 2); S8.next(4, u8); s2 = u8.pm; S8.init(MROWS, DM, 256, 3); S8.next(4, u8); s3 = u8.pm;
      S8.init(MROWS, DM, 256, 4); S8.next(4, u8); s4 = u8.pm; S8.init(MROWS, DM, 256, 5); S8.next(4, u8); s5 = u8.pm; S8.init(MROWS, DM, 256, 6); S8.next(4, u8); s6 = u8.pm; S8.init(MROWS, DM, 256, 7); S8.next(4, u8); s7 = u8.pm; }
    f32x4 gv[4], bv[4];
#pragma unroll
    for (int i = 0; i < 4; ++i) { gv[i] = *(const f32x4*)(g + i * 256 + lane * 4); bv[i] = *(const f32x4*)(b + i * 256 + lane * 4); }
    if (part == 0) {
        const int wg = (int)blockIdx.x - 8, nwg = (int)gridDim.x - 8;
        for (int row = wg * 8 + wave; row < MROWS; row += nwg * 8) {
            const int t = row >> 8;
            if (t == s0 || t == s1 || t == s2 || t == s3 || t == s4 || t == s5 || t == s6 || t == s7) continue;
            ln_row(row, lane, R, gv, bv, xb, outp, outs, stats);
        }
    } else {
        for (int idx = blockIdx.x * 8 + wave; idx < 8 * 256; idx += gridDim.x * 8) {
            const int j = idx >> 8, t = j == 0 ? s0 : j == 1 ? s1 : j == 2 ? s2 : j == 3 ? s3 : j == 4 ? s4 : j == 5 ? s5 : j == 6 ? s6 : s7;
            ln_row(t * 256 + (idx & 255), lane, R, gv, bv, xb, outp, outs, stats);
        }
    }
}
__device__ void ln_phase(float* R, const float* g, const float* b, bf16_t* xb, float* outp, float* outs, float* stats) {
    const int tid = fresh_tid(), lane = tid & 63, wave = tid >> 6;
    f32x4 gv[4], bv[4];
#pragma unroll
    for (int i = 0; i < 4; ++i) { gv[i] = *(const f32x4*)(g + i * 256 + lane * 4); bv[i] = *(const f32x4*)(b + i * 256 + lane * 4); }
    for (int row = blockIdx.x * 8 + wave; row < MROWS; row += gridDim.x * 8) {
        float* rp = R + (size_t)row * DM;
        f32x4 v[4]; float s = 0.f;
#pragma unroll
        for (int i = 0; i < 4; ++i) { v[i] = *(const f32x4*)(rp + i * 256 + lane * 4); s += (v[i][0] + v[i][1]) + (v[i][2] + v[i][3]); }
        const float mean = wave_sum(s) * (1.0f / 1024.0f);
        float q = 0.f;
#pragma unroll
        for (int i = 0; i < 4; ++i) { v[i] = v[i] - mean; q += (v[i][0] * v[i][0] + v[i][1] * v[i][1]) + (v[i][2] * v[i][2] + v[i][3] * v[i][3]); }
        const float rstd = 1.0f / sqrtf(wave_sum(q) * (1.0f / 1024.0f) + 1e-5f);
        float* op = outp ? ((row < MP) ? outp + (size_t)row * DM : outs + (size_t)(row - MP) * DM) : rp;
        if (stats && lane == 0) *(f32x2s*)(stats + 2 * (size_t)row) = (f32x2s){mean, rstd};
#pragma unroll
        for (int i = 0; i < 4; ++i) { const f32x4 y = v[i] * rstd * gv[i] + bv[i];
            if (!stats) *(f32x4*)(op + i * 256 + lane * 4) = y;
            if (xb) { u32x2 w; w.x = pg8::cvt_pk_bf16(y[0], y[1]); w.y = pg8::cvt_pk_bf16(y[2], y[3]); *(u32x2*)(xb + (size_t)row * DM + i * 256 + lane * 4) = w; } }
    }
}

__device__ void mixprep_phase(int l, const bf16_t* Z, bf16_t* pooled, bf16_t* lora_a) {
    const Params& p = fresh_params();
    const size_t gt = (size_t)blockIdx.x * NTHREADS + fresh_tid(), gs = (size_t)gridDim.x * NTHREADS;
    const float* hist_all = p.in[4] + (size_t)l * 16 * 15 * 256;
    for (size_t task = gt; task < (size_t)MROWS * 32; task += gs) {
        const int row = (int)(task >> 5), c8 = (int)(task & 31), col = c8 * 8, w = 2 << (c8 >> 3);
        const bool samp = row >= MP; const int b = samp ? ((row - MP) >> 5) : (row >> 12), t = samp ? ((row - MP) & 31) : (row & 4095);
        float acc[8], u0[8];
#pragma unroll
        for (int j = 0; j < 8; ++j) acc[j] = 0.f;
        for (int d = 0; d < w; ++d) {
            const int tt = t - d;
            if (tt >= 0) { const u32x4 q = *(const u32x4*)(Z + (size_t)(row - d) * NIN + col);
                const float f0 = bf_lo(q.x), f1 = bf_hi(q.x), f2 = bf_lo(q.y), f3 = bf_hi(q.y), f4 = bf_lo(q.z), f5 = bf_hi(q.z), f6 = bf_lo(q.w), f7 = bf_hi(q.w);
                if (d == 0) { u0[0] = f0; u0[1] = f1; u0[2] = f2; u0[3] = f3; u0[4] = f4; u0[5] = f5; u0[6] = f6; u0[7] = f7; }
                acc[0] += f0; acc[1] += f1; acc[2] += f2; acc[3] += f3; acc[4] += f4; acc[5] += f5; acc[6] += f6; acc[7] += f7; }
            else if (samp) { const float* hp = hist_all + ((size_t)b * 15 + (15 + tt)) * 256 + col; const f32x4 a = *(const f32x4*)hp, c = *(const f32x4*)(hp + 4);
                acc[0] += a[0]; acc[1] += a[1]; acc[2] += a[2]; acc[3] += a[3]; acc[4] += c[0]; acc[5] += c[1]; acc[6] += c[2]; acc[7] += c[3]; }
        }
        const float inv = 1.0f / (float)(samp ? w : ((t + 1 < w) ? (t + 1) : w));
        u32x4 o; o.x = pg8::cvt_pk_bf16(acc[0] * inv - u0[0], acc[1] * inv - u0[1]); o.y = pg8::cvt_pk_bf16(acc[2] * inv - u0[2], acc[3] * inv - u0[3]);
        o.z = pg8::cvt_pk_bf16(acc[4] * inv - u0[4], acc[5] * inv - u0[5]); o.w = pg8::cvt_pk_bf16(acc[6] * inv - u0[6], acc[7] * inv - u0[7]);
        *(u32x4*)(pooled + (size_t)row * 256 + col) = o;
        const int T = samp ? 32 : 4096;
        if (t >= T - 15) { float* op = p.out + (samp ? O_PS : O_PP) + (((size_t)l * 16 + b) * 15 + (t - (T - 15))) * 256 + col;
            *(f32x4*)op = (f32x4){u0[0], u0[1], u0[2], u0[3]}; *(f32x4*)(op + 4) = (f32x4){u0[4], u0[5], u0[6], u0[7]}; }
    }
    {
        const float* mu = p.in[18] + (size_t)l * 2560 + 2304;
        for (size_t task = gt; task < (size_t)MROWS * 32; task += gs) {
            const int row = (int)(task >> 5), q8 = (int)(task & 31), col = q8 * 8;
            const bool samp = row >= MP; const int b = samp ? ((row - MP) >> 5) : (row >> 12), t = samp ? ((row - MP) & 31) : (row & 4095);
            const u32x4 q = *(const u32x4*)(Z + (size_t)row * NIN + 256 + 2304 + col);
            float cur[8] = {bf_lo(q.x), bf_hi(q.x), bf_lo(q.y), bf_hi(q.y), bf_lo(q.z), bf_hi(q.z), bf_lo(q.w), bf_hi(q.w)};
            float prv[8];
            if (t > 0) { const u32x4 r = *(const u32x4*)(Z + (size_t)(row - 1) * NIN + 256 + 2304 + col);
                prv[0] = bf_lo(r.x); prv[1] = bf_hi(r.x); prv[2] = bf_lo(r.y); prv[3] = bf_hi(r.y); prv[4] = bf_lo(r.z); prv[5] = bf_hi(r.z); prv[6] = bf_lo(r.w); prv[7] = bf_hi(r.w); }
            else if (samp) { const float* sp = p.in[5] + ((size_t)l * 16 + b) * 2560 + 2304 + col; const f32x4 x = *(const f32x4*)sp, y = *(const f32x4*)(sp + 4);
                prv[0] = x[0]; prv[1] = x[1]; prv[2] = x[2]; prv[3] = x[3]; prv[4] = y[0]; prv[5] = y[1]; prv[6] = y[2]; prv[7] = y[3]; }
            else {
#pragma unroll
                for (int j = 0; j < 8; ++j) prv[j] = 0.f; }
            const f32x4 m0 = *(const f32x4*)(mu + col), m1 = *(const f32x4*)(mu + col + 4);
            float zs[8];
#pragma unroll
            for (int j = 0; j < 8; ++j) { zs[j] = cur[j] + (prv[j] - cur[j]) * (j < 4 ? m0[j] : m1[j - 4]); }
            if (q8 < 8) {
#pragma unroll
                for (int j = 0; j < 8; ++j) zs[j] = ftanh(zs[j]); }
            else if (q8 >= 16) {
#pragma unroll
                for (int j = 0; j < 8; ++j) zs[j] = fsig(zs[j]); }
            u32x4 w; w.x = pg8::cvt_pk_bf16(zs[0], zs[1]); w.y = pg8::cvt_pk_bf16(zs[2], zs[3]); w.z = pg8::cvt_pk_bf16(zs[4], zs[5]); w.w = pg8::cvt_pk_bf16(zs[6], zs[7]);
            *(u32x4*)(lora_a + (size_t)row * 256 + col) = w;
        }
    }
    for (size_t i = gt; i < (size_t)32 * 2560; i += gs) {
        const int s = (int)(i / 2560), c = (int)(i % 2560); const bool samp = s >= 16; const int b = s & 15;
        const int row = samp ? (MP + b * 32 + 31) : (b * 4096 + 4095);
        p.out[(samp ? O_SS : O_SP) + ((size_t)l * 16 + b) * 2560 + c] = __uint_as_float((unsigned)Z[(size_t)row * NIN + 256 + c] << 16);
    }
}

constexpr int TC = 16;
constexpr int RS = 68;
constexpr int MS = 20;
constexpr int NBUF = 4;
constexpr int B_R = 0, B_K = 4352, B_V = 8704, B_A = 13056, B_B = 17408, B_G = 21760, B_Y = 25856, B_PC = 29952, B_BON = 30208, BUFSZ = 30272;
constexpr int SC_W2 = 121088, SC_A2 = 130304, SC_G2 = 139520, SC_CTR = 156928;
constexpr int XS = 72, XGS = 136;
typedef float f32x2 __attribute__((ext_vector_type(2)));
__device__ __forceinline__ float rowsum16(float v) { v += dpp_mov<0xB1>(v); v += dpp_mov<0x4E>(v); v += dpp_mov<0x141>(v); v += dpp_mov<0x140>(v); return v; }
template <int CTRL> __device__ __forceinline__ float dpp_shr1(float v) { return __builtin_bit_cast(float, __builtin_amdgcn_update_dpp(0x3f800000, __builtin_bit_cast(int, v), CTRL, 0xF, 0xF, false)); }
__device__ __forceinline__ float rowprefix_mul(float p) { p *= dpp_shr1<0x111>(p); p *= dpp_shr1<0x112>(p); p *= dpp_shr1<0x114>(p); p *= dpp_shr1<0x118>(p); return p; }
__device__ __forceinline__ void lds_wait_ge(LAS unsigned* ctr, unsigned want) {
    while (__hip_atomic_load(ctr, __ATOMIC_ACQUIRE, __HIP_MEMORY_SCOPE_WORKGROUP) < want) {}
}
__device__ __forceinline__ void prep_bar(LAS unsigned* ctr, unsigned& gen, int lane) {
    gen += 4u;
    if (lane == 0) __hip_atomic_fetch_add(ctr, 1u, __ATOMIC_RELEASE, __HIP_MEMORY_SCOPE_WORKGROUP);
    while (__hip_atomic_load(ctr, __ATOMIC_ACQUIRE, __HIP_MEMORY_SCOPE_WORKGROUP) < gen) {}
}
#define MFMA4(a, b, c) __builtin_amdgcn_mfma_f32_16x16x4f32((a), (b), (c), 0, 0, 0)
#define MFMAB(a, b, c) __builtin_amdgcn_mfma_f32_16x16x32_bf16((a), (b), (c), 0, 0, 0)
__device__ __forceinline__ bf16x8 cvt4z(f32x4 lo) { u32x4 w; w.x = pg8::cvt_pk_bf16(lo[0], lo[1]); w.y = pg8::cvt_pk_bf16(lo[2], lo[3]); w.z = 0u; w.w = 0u; return __builtin_bit_cast(bf16x8, w); }
__device__ __forceinline__ bf16x8 cvt8(f32x4 lo, f32x4 hi) { u32x4 w; w.x = pg8::cvt_pk_bf16(lo[0], lo[1]); w.y = pg8::cvt_pk_bf16(lo[2], lo[3]); w.z = pg8::cvt_pk_bf16(hi[0], hi[1]); w.w = pg8::cvt_pk_bf16(hi[2], hi[3]); return __builtin_bit_cast(bf16x8, w); }

__device__ void scan_phase(int l, const bf16_t* Z, const bf16_t* lora_a, bf16_t* mixin, LAS unsigned char* lds) {
    const Params& p = fresh_params();
    const int tid = fresh_tid(), lane = tid & 63, wave = __builtin_amdgcn_readfirstlane(tid >> 6);
    LAS bf16_t* w2t = (LAS bf16_t*)(lds + SC_W2); LAS bf16_t* a2t = (LAS bf16_t*)(lds + SC_A2); LAS bf16_t* g2t = (LAS bf16_t*)(lds + SC_G2);
    LAS unsigned* ctr = (LAS unsigned*)(lds + SC_CTR);
    const float* mu = p.in[18] + (size_t)l * 2560;
    const int fr = lane & 15, fq = lane >> 4;
    for (int unit = blockIdx.x; unit < 384; unit += gridDim.x) {
        const bool samp = unit >= 192; const int uu = samp ? unit - 192 : unit, b = uu / 12, h = uu % 12;
        const int T = samp ? 32 : 4096, row0 = samp ? (MP + b * 32) : (b * 4096), NC = T / TC;
        __syncthreads();
        for (int i = tid; i < 64 * 64; i += NTHREADS) { const int k = i >> 6, n = i & 63;
            w2t[n * XS + k] = f2bf(p.in[22][((size_t)l * 64 + k) * 768 + h * 64 + n]);
            a2t[n * XS + k] = f2bf(p.in[24][((size_t)l * 64 + k) * 768 + h * 64 + n]); }
        for (int i = tid; i < 128 * 64; i += NTHREADS) { const int k = i >> 6, n = i & 63;
            g2t[n * XGS + k] = f2bf(p.in[25][((size_t)l * 128 + k) * 768 + h * 64 + n]); }
        if (tid < 8) ctr[tid] = 0u;
        __syncthreads();
        if (wave < 4) {
            const int vt = wave;
            f32x4 H0, H1, H2, H3;
            const size_t sbase = ((((size_t)l * 16 + b) * 12 + h) * 64 + vt * 16 + fr) * 64 + 4 * fq;
            if (samp) { const float* sp = p.in[6] + sbase; H0 = *(const f32x4*)sp; H1 = *(const f32x4*)(sp + 16); H2 = *(const f32x4*)(sp + 32); H3 = *(const f32x4*)(sp + 48); }
            else { H0 = (f32x4){0.f, 0.f, 0.f, 0.f}; H1 = H0; H2 = H0; H3 = H0; }
            asm volatile("" : "+v"(H0), "+v"(H1), "+v"(H2), "+v"(H3));
#pragma unroll 1
            for (int c = 0; c < NC; ++c) {
                const int bi = c % NBUF;
                lds_wait_ge(ctr + bi, (unsigned)(c + 1));
                LAS unsigned char* bb = lds + bi * BUFSZ;
                const LAS float* opR = (const LAS float*)(bb + B_R); const LAS float* opK = (const LAS float*)(bb + B_K); const LAS float* opV = (const LAS float*)(bb + B_V);
                const LAS float* opA = (const LAS float*)(bb + B_A); const LAS float* opB = (const LAS float*)(bb + B_B); LAS float* yB = (LAS float*)(bb + B_Y);
                const int ro = fr * RS + 4 * fq;
                const f32x4 a0 = *(const LAS f32x4*)(opA + ro), a1 = *(const LAS f32x4*)(opA + ro + 16), a2 = *(const LAS f32x4*)(opA + ro + 32), a3 = *(const LAS f32x4*)(opA + ro + 48);
                const f32x4 r0 = *(const LAS f32x4*)(opR + ro), r1 = *(const LAS f32x4*)(opR + ro + 16), r2 = *(const LAS f32x4*)(opR + ro + 32), r3 = *(const LAS f32x4*)(opR + ro + 48);
                const f32x4 b0 = *(const LAS f32x4*)(opB + ro), b1 = *(const LAS f32x4*)(opB + ro + 16), b2 = *(const LAS f32x4*)(opB + ro + 32), b3 = *(const LAS f32x4*)(opB + ro + 48);
                const f32x4 k0 = *(const LAS f32x4*)(opK + ro), k1 = *(const LAS f32x4*)(opK + ro + 16), k2 = *(const LAS f32x4*)(opK + ro + 32), k3 = *(const LAS f32x4*)(opK + ro + 48);
                f32x4 W = {0.f, 0.f, 0.f, 0.f}, Y = W;
                f32x4 LA = W, LD = W, KA = W, NbA = W, NkA = W;
                { const bf16x8 hb0 = cvt8(H0, H1), hb1 = cvt8(H2, H3);
                    const bf16x8 fa0 = cvt8(a0, a1), fa1 = cvt8(a2, a3), fr0 = cvt8(r0, r1), fr1 = cvt8(r2, r3);
                    const bf16x8 fb0 = cvt8(b0, b1), fb1 = cvt8(b2, b3), fk0 = cvt8(k0, k1), fk1 = cvt8(k2, k3);
                    W = MFMAB(fa0, hb0, W); W = MFMAB(fa1, hb1, W);
                    Y = MFMAB(fr0, hb0, Y); Y = MFMAB(fr1, hb1, Y);
                    LA = MFMAB(fb0, fa0, LA); LA = MFMAB(fb1, fa1, LA);
                    LD = MFMAB(fa0, fb0, LD); LD = MFMAB(fa1, fb1, LD);
                    KA = MFMAB(fk0, fa0, KA); KA = MFMAB(fk1, fa1, KA);
                    NbA = MFMAB(fb0, fr0, NbA); NbA = MFMAB(fb1, fr1, NbA);
                    NkA = MFMAB(fk0, fr0, NkA); NkA = MFMAB(fk1, fr1, NkA);
                }
#pragma unroll
                for (int j = 0; j < 4; ++j) { const int sA = 4 * fq + j;
                    LA[j] = (sA < fr) ? LA[j] : 0.f; KA[j] = (sA < fr) ? KA[j] : 0.f; NbA[j] = (sA <= fr) ? NbA[j] : 0.f; NkA[j] = (sA <= fr) ? NkA[j] : 0.f;
                    LD[j] = (fr < sA) ? LD[j] : 0.f; }
                const f32x4 Z4 = {0.f, 0.f, 0.f, 0.f};
                const bf16x8 fLA = cvt4z(LA), fLD = cvt4z(LD);
                const f32x4 L2A = MFMAB(fLD, fLA, Z4), L2D = MFMAB(fLA, fLD, Z4);
                const bf16x8 fL2A = cvt4z(L2A), fL2D = cvt4z(L2D);
                const f32x4 L4A = MFMAB(fL2D, fL2A, Z4), L4D = MFMAB(fL2A, fL2D, Z4);
                const bf16x8 fL4A = cvt4z(L4A), fL4D = cvt4z(L4D);
                const f32x4 L8A = MFMAB(fL4D, fL4A, Z4);
                f32x4 Vr;
#pragma unroll
                for (int j = 0; j < 4; ++j) Vr[j] = opV[(4 * fq + j) * RS + vt * 16 + fr];
                W = MFMAB(cvt4z(KA), cvt4z(Vr), W);
                W = MFMAB(fLA, cvt4z(W), W);
                W = MFMAB(fL2A, cvt4z(W), W);
                W = MFMAB(fL4A, cvt4z(W), W);
                W = MFMAB(cvt4z(L8A), cvt4z(W), W);
                const bf16x8 uvb = cvt8(W, Vr);
                Y = MFMAB(cvt8(NbA, NkA), uvb, Y);
#pragma unroll
                for (int j = 0; j < 4; ++j) yB[(4 * fq + j) * 64 + vt * 16 + fr] = Y[j];
                {
                    f32x4 bq0, bq1, bq2, bq3, kq0, kq1, kq2, kq3;
#pragma unroll
                    for (int j = 0; j < 4; ++j) { const int o = (4 * fq + j) * RS + fr;
                        bq0[j] = opB[o]; bq1[j] = opB[o + 16]; bq2[j] = opB[o + 32]; bq3[j] = opB[o + 48];
                        kq0[j] = opK[o]; kq1[j] = opK[o + 16]; kq2[j] = opK[o + 32]; kq3[j] = opK[o + 48]; }
                    H0 = MFMAB(cvt8(bq0, kq0), uvb, H0); H1 = MFMAB(cvt8(bq1, kq1), uvb, H1); H2 = MFMAB(cvt8(bq2, kq2), uvb, H2); H3 = MFMAB(cvt8(bq3, kq3), uvb, H3);
                }
                { const LAS float* pc = (const LAS float*)(bb + B_PC) + 4 * fq;
                    H0 = H0 * *(const LAS f32x4*)pc; H1 = H1 * *(const LAS f32x4*)(pc + 16); H2 = H2 * *(const LAS f32x4*)(pc + 32); H3 = H3 * *(const LAS f32x4*)(pc + 48); }
                if (lane == 0) __hip_atomic_store(ctr + 4 + vt, (unsigned)(c + 1), __ATOMIC_RELEASE, __HIP_MEMORY_SCOPE_WORKGROUP);
            }
            { float* sp = p.out + (samp ? O_WS : O_WP) + sbase; *(f32x4*)sp = H0; *(f32x4*)(sp + 16) = H1; *(f32x4*)(sp + 32) = H2; *(f32x4*)(sp + 48) = H3; }
        } else {
            const int pw = wave - 4;
            __builtin_amdgcn_s_setprio(2);
            const int ecg = lane & 15;
            const int hc4 = l * 768 + h * 64 + 4 * ecg;
            const f32x4 c_kk = *(const f32x4*)(p.in[26] + hc4), c_ka = *(const f32x4*)(p.in[27] + hc4), c_rk = *(const f32x4*)(p.in[28] + hc4);
            const f32x4 c_lg = *(const f32x4*)(p.in[29] + hc4), c_lb = *(const f32x4*)(p.in[30] + hc4);
            f32x4 cw0, ca0;
#pragma unroll
            for (int nt = 0; nt < 4; ++nt) { cw0[nt] = p.in[21][l * 768 + h * 64 + nt * 16 + fr]; ca0[nt] = p.in[23][l * 768 + h * 64 + nt * 16 + fr]; }
            const int cc = lane;
            const bool act1 = cc < 24;
            const int zc = ((act1 ? cc : 23) >> 3) * 768 + h * 64 + (cc & 7) * 8;
            const f32x4 m0 = *(const f32x4*)(mu + zc), m1 = *(const f32x4*)(mu + zc + 4);
            const bf16_t* zbase = Z + (size_t)row0 * NIN + 256 + zc;
            LAS unsigned char* bb = lds + pw * BUFSZ;
            LAS float* opR = (LAS float*)(bb + B_R); LAS float* opK = (LAS float*)(bb + B_K); LAS float* opV = (LAS float*)(bb + B_V);
            LAS float* opA = (LAS float*)(bb + B_A); LAS float* opB = (LAS float*)(bb + B_B); LAS float* gV = (LAS float*)(bb + B_G); LAS float* aL = (LAS float*)(bb + B_Y);
#define LDS_FENCE() asm volatile("s_waitcnt lgkmcnt(0)" ::: "memory")
            f32x4 pv0 = {0.f, 0.f, 0.f, 0.f}, pv1 = pv0;
            if (samp) { const float* sp = p.in[5] + ((size_t)l * 16 + b) * 2560 + zc; pv0 = *(const f32x4*)sp; pv1 = *(const f32x4*)(sp + 4); }
            asm volatile("" : "+v"(pv0), "+v"(pv1));
            u32x4 qq[16], qprev = {0u, 0u, 0u, 0u};
#pragma unroll
            for (int i = 0; i < 16; ++i) qq[i] = qprev;
            { const int c0 = pw < NC ? pw : NC - 1; const bf16_t* zp = zbase + (size_t)(c0 * TC) * NIN;
                qprev = *(const u32x4*)(zp - (c0 > 0 ? NIN : 0));
#pragma unroll
                for (int i = 0; i < 16; ++i) qq[i] = *(const u32x4*)(zp + (size_t)i * NIN); }
#pragma unroll 1
            for (int c = pw; c < NC + NBUF; c += NBUF) {
                if (c >= NBUF) {
                    { const unsigned want = (unsigned)(c - NBUF + 1); lds_wait_ge(ctr + 4, want); lds_wait_ge(ctr + 5, want); lds_wait_ge(ctr + 6, want); lds_wait_ge(ctr + 7, want); }
#pragma unroll 1
                    for (int it = 0; it < 4; ++it) {
                        const int etl = 4 * it + (lane >> 4), o = etl * 64 + 4 * ecg;
                        const f32x4 y = *(const LAS f32x4*)((LAS float*)(bb + B_Y) + o), v = *(const LAS f32x4*)(opV + etl * RS + 4 * ecg), g = *(const LAS f32x4*)(gV + o);
                        const float mean = rowsum16((y[0] + y[1]) + (y[2] + y[3])) * (1.0f / 64.0f);
                        const f32x4 d = y - mean;
                        const float var = rowsum16((d[0] * d[0] + d[1] * d[1]) + (d[2] * d[2] + d[3] * d[3])) * (1.0f / 64.0f);
                        const f32x4 ov = (d * (1.0f / sqrtf(var + 64e-5f)) * c_lg + c_lb + ((LAS float*)(bb + B_BON))[etl] * v) * g;
                        u32x2 w; w.x = pg8::cvt_pk_bf16(ov[0], ov[1]); w.y = pg8::cvt_pk_bf16(ov[2], ov[3]);
                        *(u32x2*)(mixin + ((size_t)row0 + (c - NBUF) * TC + etl) * DM + 256 + h * 64 + 4 * ecg) = w;
                    }
                    LDS_FENCE();
                }
                if (c < NC) {
                const bf16_t* lp = lora_a + ((size_t)row0 + (size_t)c * TC + fr) * 256 + fq * 8;
                const bf16x8 xw0 = *(const bf16x8*)(lp), xw1 = *(const bf16x8*)(lp + 32), xl0 = *(const bf16x8*)(lp + 64), xl1 = *(const bf16x8*)(lp + 96);
                const bf16x8 xg0 = *(const bf16x8*)(lp + 128), xg1 = *(const bf16x8*)(lp + 160), xg2 = *(const bf16x8*)(lp + 192), xg3 = *(const bf16x8*)(lp + 224);
                if (act1) {
                    float prv[8];
                    if (c > 0) { const u32x4 q = qprev;
                        prv[0] = bf_lo(q.x); prv[1] = bf_hi(q.x); prv[2] = bf_lo(q.y); prv[3] = bf_hi(q.y); prv[4] = bf_lo(q.z); prv[5] = bf_hi(q.z); prv[6] = bf_lo(q.w); prv[7] = bf_hi(q.w); }
                    else { prv[0] = pv0[0]; prv[1] = pv0[1]; prv[2] = pv0[2]; prv[3] = pv0[3]; prv[4] = pv1[0]; prv[5] = pv1[1]; prv[6] = pv1[2]; prv[7] = pv1[3]; }
                    LAS float* dst0 = (cc < 8 ? opR : (cc < 16 ? opK : opV)) + (cc & 7) * 8;
#pragma unroll
                    for (int i = 0; i < 16; ++i) {
                        const u32x4 q = qq[i];
                        float cur[8] = {bf_lo(q.x), bf_hi(q.x), bf_lo(q.y), bf_hi(q.y), bf_lo(q.z), bf_hi(q.z), bf_lo(q.w), bf_hi(q.w)};
                        float zs[8];
#pragma unroll
                        for (int j = 0; j < 8; ++j) { zs[j] = cur[j] + (prv[j] - cur[j]) * (j < 4 ? m0[j] : m1[j - 4]); prv[j] = cur[j]; }
                        *(LAS f32x4*)(dst0 + i * RS) = (f32x4){zs[0], zs[1], zs[2], zs[3]}; *(LAS f32x4*)(dst0 + i * RS + 4) = (f32x4){zs[4], zs[5], zs[6], zs[7]};
                    }
                }
                { const int cn = (c + NBUF < NC) ? c + NBUF : NC - 1; const bf16_t* zp = zbase + (size_t)(cn * TC) * NIN;
                    qprev = *(const u32x4*)(zp - (cn > 0 ? NIN : 0));
#pragma unroll
                    for (int i = 0; i < 16; ++i) qq[i] = *(const u32x4*)(zp + (size_t)i * NIN); }
                LDS_FENCE();
#pragma unroll 1
                for (int nt = 0; nt < 4; ++nt) {
                    f32x4 dw = {0.f, 0.f, 0.f, 0.f}, da = dw, dg = dw;
                    { const LAS bf16_t* wp = w2t + (nt * 16 + fr) * XS + fq * 8; const LAS bf16_t* ap = a2t + (nt * 16 + fr) * XS + fq * 8; const LAS bf16_t* gp = g2t + (nt * 16 + fr) * XGS + fq * 8;
                        dw = __builtin_amdgcn_mfma_f32_16x16x32_bf16(xw0, *(const LAS bf16x8*)wp, dw, 0, 0, 0); dw = __builtin_amdgcn_mfma_f32_16x16x32_bf16(xw1, *(const LAS bf16x8*)(wp + 32), dw, 0, 0, 0);
                        da = __builtin_amdgcn_mfma_f32_16x16x32_bf16(xl0, *(const LAS bf16x8*)ap, da, 0, 0, 0); da = __builtin_amdgcn_mfma_f32_16x16x32_bf16(xl1, *(const LAS bf16x8*)(ap + 32), da, 0, 0, 0);
                        dg = __builtin_amdgcn_mfma_f32_16x16x32_bf16(xg0, *(const LAS bf16x8*)gp, dg, 0, 0, 0); dg = __builtin_amdgcn_mfma_f32_16x16x32_bf16(xg1, *(const LAS bf16x8*)(gp + 32), dg, 0, 0, 0);
                        dg = __builtin_amdgcn_mfma_f32_16x16x32_bf16(xg2, *(const LAS bf16x8*)(gp + 64), dg, 0, 0, 0); dg = __builtin_amdgcn_mfma_f32_16x16x32_bf16(xg3, *(const LAS bf16x8*)(gp + 96), dg, 0, 0, 0); }
                    const float w0n = nt == 0 ? cw0[0] : nt == 1 ? cw0[1] : nt == 2 ? cw0[2] : cw0[3], a0n = nt == 0 ? ca0[0] : nt == 1 ? ca0[1] : nt == 2 ? ca0[2] : ca0[3];
                    f32x4 e, E = {0.f, 0.f, 0.f, 0.f};
#pragma unroll
                    for (int j = 0; j < 4; ++j) e[j] = -0.8750402888f * fsig(w0n + dw[j]);
#pragma unroll
                    for (int j = 0; j < 4; ++j) E = MFMA4((4 * fq + j <= fr) ? 1.0f : 0.0f, e[j], E);
#pragma unroll
                    for (int j = 0; j < 4; ++j) { const int t = 4 * fq + j, n = nt * 16 + fr;
                        const float P = __builtin_amdgcn_exp2f(E[j]);
                        opB[t * RS + n] = P; opA[t * RS + n] = __builtin_amdgcn_exp2f(E[j] - e[j]);
                        if (t == 15) ((LAS float*)(bb + B_PC))[n] = P;
                        aL[t * 64 + n] = fsig(a0n + da[j]); gV[t * 64 + n] = dg[j]; }
                }
                LDS_FENCE();
#pragma unroll 1
                for (int it = 0; it < 4; ++it) {
                    const int etl = 4 * it + (lane >> 4), o = etl * RS + 4 * ecg;
                    const f32x4 kr = *(const LAS f32x4*)(opK + o), a = *(const LAS f32x4*)(aL + etl * 64 + 4 * ecg), r = *(const LAS f32x4*)(opR + o);
                    const f32x4 P = *(const LAS f32x4*)(opB + o), Pex = *(const LAS f32x4*)(opA + o);
                    f32x4 kk = kr * c_kk;
                    const float nn = rowsum16((kk[0] * kk[0] + kk[1] * kk[1]) + (kk[2] * kk[2] + kk[3] * kk[3]));
                    kk = kk * (1.0f / fmaxf(sqrtf(nn), 1e-12f));
                    const f32x4 kp = kr * (1.0f + (a - 1.0f) * c_ka);
                    f32x4 inv;
#pragma unroll
                    for (int j = 0; j < 4; ++j) inv[j] = __builtin_amdgcn_rcpf(P[j]);
                    *(LAS f32x4*)(opK + o) = kp * inv; *(LAS f32x4*)(opA + o) = -kk * Pex; *(LAS f32x4*)(opB + o) = kk * a * inv; *(LAS f32x4*)(opR + o) = r * P;
                    const f32x4 rb = r * kp * c_rk;
                    const float bs = rowsum16((rb[0] + rb[1]) + (rb[2] + rb[3]));
                    if (ecg == 0) ((LAS float*)(bb + B_BON))[etl] = bs;
                }
                LDS_FENCE();
                LDS_FENCE();
                if (lane == 0) __hip_atomic_store(ctr + pw, (unsigned)(c + 1), __ATOMIC_RELEASE, __HIP_MEMORY_SCOPE_WORKGROUP);
                }
            }
            __builtin_amdgcn_s_setprio(0);
        }
#undef LDS_FENCE
    }
    __syncthreads();
}
#undef MFMA4

#define XB_TMO      128
#define XB_XCNT(j)  (256  + 64 * (j))
#define XB_XSUB(j)  (1280 + 64 * (j))
#define XB_XGEN(j)  (2304 + 64 * (j))
#define XB_TOP      3328
#define XB_TOPGEN   3392
#define XCD_BAR_WORDS 3456
#define XB_SPIN_CAP (1u << 18)

__device__ __forceinline__ unsigned xb_ld(unsigned* p)              { return __hip_atomic_load(p, __ATOMIC_RELAXED, __HIP_MEMORY_SCOPE_AGENT); }
__device__ __forceinline__ unsigned xb_add(unsigned* p, unsigned v) { return __hip_atomic_fetch_add(p, v, __ATOMIC_RELAXED, __HIP_MEMORY_SCOPE_AGENT); }
__device__ __forceinline__ unsigned xb_xcc_id() { return (unsigned)__builtin_amdgcn_s_getreg((3 << 11) | 20) & 0xFu; }
#define XB_SPIN(cond, bar) do { unsigned _sp = 0; while (cond) { __builtin_amdgcn_s_sleep(1); \
    if ((++_sp & 255u) == 0u) { if (xb_ld(&(bar)[XB_TMO])) break; if (_sp > XB_SPIN_CAP) { atomicAdd(&(bar)[XB_TMO], 1u); break; } } } } while (0)

struct XcdBarrier {
    unsigned* bar; unsigned x;
    volatile LAS unsigned* st;
};

__device__ __forceinline__ XcdBarrier xcd_barrier_post(unsigned* bar, volatile LAS unsigned* st) {
    XcdBarrier b; b.bar = bar; b.x = xb_xcc_id(); b.st = st;
    if (threadIdx.x == 0) (void)xb_add(&bar[XB_XCNT(b.x)], 1u);
    return b;
}
__device__ __forceinline__ void xcd_barrier_complete(unsigned* bar, unsigned x, unsigned& nloc, unsigned& nx) {
    const unsigned G = gridDim.x * gridDim.y * gridDim.z;
    unsigned sum, cnt, mine, sp = 0u;
    for (;;) {
        sum = 0u; cnt = 0u; mine = 0u;
#pragma unroll
        for (unsigned j = 0; j < 16; ++j) { const unsigned c = xb_ld(&bar[XB_XCNT(j)]); sum += c; cnt += (c > 0u) ? 1u : 0u; mine = (j == x) ? c : mine; }
        if (sum == G) break;
        __builtin_amdgcn_s_sleep(1);
        if ((++sp & 255u) == 0u) { if (xb_ld(&bar[XB_TMO])) break; if (sp > XB_SPIN_CAP) { atomicAdd(&bar[XB_TMO], 1u); break; } }
    }
    nloc = mine > 0u ? mine : 1u; nx = cnt > 0u ? cnt : 1u;
}

__device__ __forceinline__ void xcd_barrier(const XcdBarrier& b) {
    asm volatile("s_waitcnt vmcnt(0)" ::: "memory");
    __syncthreads();
    if (threadIdx.x == 0) {
        unsigned* bar = b.bar;
        __builtin_amdgcn_s_waitcnt(0);
        unsigned nloc = b.st[0], nx = b.st[1];
        if (nloc == 0u) { xcd_barrier_complete(bar, b.x, nloc, nx); b.st[0] = nloc; b.st[1] = nx; }
        const unsigned old = xb_add(&bar[XB_XSUB(b.x)], 1u);
        const unsigned gen = old / nloc;
        if (old + 1u == (gen + 1u) * nloc) {
            __builtin_amdgcn_fence(__ATOMIC_RELEASE, "agent");
            asm volatile("s_waitcnt vmcnt(0)" ::: "memory");
            const unsigned og = xb_add(&bar[XB_TOP], 1u);
            const unsigned tg = og / nx;
            if (og + 1u == (tg + 1u) * nx) xb_add(&bar[XB_TOPGEN], 1u);
            else XB_SPIN(xb_ld(&bar[XB_TOPGEN]) == tg, bar);
            __builtin_amdgcn_fence(__ATOMIC_ACQUIRE, "agent");
            xb_add(&bar[XB_XGEN(b.x)], 1u);
            asm volatile("s_waitcnt vmcnt(0)" ::: "memory");
        } else {
            XB_SPIN(xb_ld(&bar[XB_XGEN(b.x)]) == gen, bar);
            __builtin_amdgcn_fence(__ATOMIC_ACQUIRE, "agent");
            asm volatile("s_waitcnt vmcnt(0)" ::: "memory");
        }
    }
    __syncthreads();
}

template <class Epi> __device__ __forceinline__ void run_gemm(LAS unsigned char* lds, const bf16_t* A, const bf16_t* Bt, int N, int K, const Epi E, int rot, int gsub = 0, int csub = 0) {
    asm volatile("" : "+s"(K), "+s"(N));
    pg8::Gemm g{A, Bt, MROWS, N, K}; pg8::StaticOrder S;
    if (gsub > 0) S.init(MROWS, N, gsub, csub);
    else S.init(MROWS, N, (int)gridDim.x, (int)((blockIdx.x + rot) % gridDim.x));
    pg8::gemm_phase<Epi, pg8::StaticOrder, false>((PG8_LAS unsigned char*)lds, g, S, E, nullptr);
}

template <class Epi> __device__ __forceinline__ void run_gemm_range(LAS unsigned char* lds, const bf16_t* A, const bf16_t* Bt, int N, int K, const Epi E, int i0, int i1) {
    asm volatile("" : "+s"(K), "+s"(N), "+s"(i0), "+s"(i1));
    pg8::Gemm g{A, Bt, MROWS, N, K}; pg8::RangeOrder S; S.init(MROWS, N, (int)gridDim.x, (int)blockIdx.x); S.i0 = i0; S.i1 = i1;
    pg8::gemm_phase<Epi, pg8::RangeOrder, false>((PG8_LAS unsigned char*)lds, g, S, E, nullptr);
}
#define COMMA ,
#define GEMM_THEN_LN(EPI_DECL, AOP, BOP, KK, LNG, LNB, XBO, OUTP, OUTS, STATSP) do { \
    if (gridDim.x == 256) { \
        _Pragma("unroll 1") for (int part = 0; part < 2; ++part) { \
            if (part == 0 || blockIdx.x < 8) { EPI_DECL; run_gemm_range(lds, AOP, BOP, DM, KK, E, part * 4, part ? 5 : 4); } \
            else ln_tiles(0, R, LNG, LNB, XBO, OUTP, OUTS, STATSP); \
            xcd_barrier(xbar); } \
        ln_tiles(1, R, LNG, LNB, XBO, OUTP, OUTS, STATSP); \
    } else { { EPI_DECL; run_gemm(lds, AOP, BOP, DM, KK, E, 0); } xcd_barrier(xbar); ln_phase(R, LNG, LNB, XBO, OUTP, OUTS, STATSP); } } while (0)
__global__ void __launch_bounds__(NTHREADS, 2) mega_fwd(Params p_unused) {
    extern __shared__ __attribute__((aligned(16))) unsigned char lds_raw[];
    LAS unsigned char* lds = (LAS unsigned char*)lds_raw;
    cg::grid_group grid = cg::this_grid();
    unsigned char* ws = fresh_params().ws;
    bf16_t* WT = (bf16_t*)(ws + OFF_WT); float* R = (float*)(ws + OFF_R); bf16_t* XB = (bf16_t*)(ws + OFF_XB); bf16_t* HZ = (bf16_t*)(ws + OFF_HZ);
    bf16_t* PB = (bf16_t*)(ws + OFF_PB); bf16_t* PPb = (bf16_t*)(ws + OFF_PP); bf16_t* POOLED = PPb; float* STATS = (float*)(ws + OFF_STATS); const float* GB = (const float*)(ws + OFF_GB);

    if (threadIdx.x < 4) ((LAS unsigned*)(lds + LDS_XB))[threadIdx.x] = 0u;
    __syncthreads();
    const XcdBarrier xbar = xcd_barrier_post((unsigned*)(ws + OFF_BAR), (volatile LAS unsigned*)(lds + LDS_XB));
    prologue(lds);
    grid.sync();
    for (int l = 0; l < 2; ++l) {
        const Params& p = fresh_params();
        const bf16_t* W = WT + (size_t)l * WT_LAYER;
        { pg8::EpiSwiglu E{HZ, DFF}; run_gemm(lds, XB, W + WT_FFN1IN, 2 * DFF, DM, E, 0); }
        xcd_barrier(xbar);
        if (l == 0) GEMM_THEN_LN(pg8::EpiResidIn E{p.in[0] COMMA p.in[1] - (size_t)MP * DM COMMA MP COMMA R COMMA ALPHA_F COMMA 0.5f}, HZ, W + WT_FFN1OUT, DFF, p.in[7] + l * DM, p.in[8] + l * DM, XB, nullptr, nullptr, STATS);
        else GEMM_THEN_LN(pg8::EpiResidLN<false COMMA true> E{R COMMA nullptr COMMA (int)(OFF_STATS - OFF_R) COMMA (int)(OFF_GB - OFF_R) + 2 * 8192}, HZ, W + WT_FFN1OUT, DFF, p.in[7] + l * DM, p.in[8] + l * DM, XB, nullptr, nullptr, STATS);
        xcd_barrier(xbar);
        { pg8::EpiStoreBf16 E{HZ, NIN, nullptr}; run_gemm(lds, XB, W + WT_WIN, NIN, DM, E, 0); }
        xcd_barrier(xbar);
        mixprep_phase(l, HZ, POOLED, POOLED + (size_t)MROWS * 256);
        xcd_barrier(xbar);
        if (gridDim.x == 256) { if (blockIdx.x >= 192) { pg8::EpiStoreBf16 E{XB, DM, p.in[20] + l * 256}; run_gemm(lds, POOLED, W + WT_POOL, 256, 256, E, 0, 64, (int)blockIdx.x - 192); } }
        else { pg8::EpiStoreBf16 E{XB, DM, p.in[20] + l * 256}; run_gemm(lds, POOLED, W + WT_POOL, 256, 256, E, 0); }
        scan_phase(l, HZ, POOLED + (size_t)MROWS * 256, XB, lds);
        xcd_barrier(xbar);
        GEMM_THEN_LN(pg8::EpiResidLN<false COMMA false> E{R COMMA nullptr COMMA (int)(OFF_STATS - OFF_R) COMMA (int)(OFF_GB - OFF_R) + (l * 3 + 0) * 8192}, XB, W + WT_WOUT, DM, p.in[9] + l * DM, p.in[10] + l * DM, XB, nullptr, nullptr, STATS);
        xcd_barrier(xbar);
        { pg8::EpiSwiglu E{HZ, DFF}; run_gemm(lds, XB, W + WT_FFN2IN, 2 * DFF, DM, E, 0); }
        xcd_barrier(xbar);
        { pg8::EpiResidLN<true, true> E{R, XB, (int)(OFF_STATS - OFF_R), (int)(OFF_GB - OFF_R) + (l * 3 + 1) * 8192}; run_gemm(lds, HZ, W + WT_FFN2OUT, DM, DFF, E, 0); }
        { pg8::EpiStoreBf16 E{PPb, DM, nullptr}; const bool sub = gridDim.x == 256;
          if (!sub || blockIdx.x >= 8) run_gemm(lds, PB + (size_t)l * MROWS * 256, W + WT_PLE, DM, 256, E, sub ? 0 : 128, sub ? 248 : 0, sub ? (int)blockIdx.x - 8 : 0); }
        xcd_barrier(xbar);
        GEMM_THEN_LN(pg8::EpiGate E{R COMMA PPb COMMA p.in[33] + l * DM COMMA DM}, XB, W + WT_GATE, DM, p.in[11] + l * DM, p.in[12] + l * DM, (l == 0 ? XB : (bf16_t*)nullptr), (l == 0 ? (float*)nullptr : p.out + O_YP), (l == 0 ? (float*)nullptr : p.out + O_YS), (l == 0 ? STATS : (float*)nullptr));
        if (l == 0) xcd_barrier(xbar);
    }
}

extern "C" void kernel_launch(void* const* d_in, const int* in_sizes, int n_in, void* d_out, int out_size, void* d_ws, size_t ws_size, hipStream_t stream) {
    static int grid_blocks = 0;
    if (grid_blocks == 0) {
        if (n_in != 35 || ws_size < WS_END) { fprintf(stderr, "kernel_launch: expected 35 inputs and >= %zu bytes of workspace, got %d and %zu\n", (size_t)WS_END, n_in, ws_size); grid_blocks = -1; return; }
        int dev = 0, cus = 0, per_cu = 0;
        hipGetDevice(&dev);
        hipDeviceGetAttribute(&cus, hipDeviceAttributeMultiprocessorCount, dev);
        if (hipFuncSetAttribute((const void*)mega_fwd, hipFuncAttributeMaxDynamicSharedMemorySize, LDS_BYTES) != hipSuccess) { fprintf(stderr, "kernel_launch: hipFuncSetAttribute failed\n"); (void)hipGetLastError(); }
        if (hipOccupancyMaxActiveBlocksPerMultiprocessor(&per_cu, (const void*)mega_fwd, NTHREADS, LDS_BYTES) != hipSuccess || per_cu < 1) { fprintf(stderr, "kernel_launch: occupancy query gave %d\n", per_cu); per_cu = 1; (void)hipGetLastError(); }
        grid_blocks = cus * per_cu;
    }
    if (grid_blocks < 0) return;
    Params p{};
    for (int i = 0; i < 35; ++i) p.in[i] = (const float*)d_in[i];
    p.out = (float*)d_out; p.ws = (unsigned char*)d_ws;
    (void)hipMemsetAsync((char*)d_ws + OFF_BAR, 0, 13824, stream);
    void* args[] = {&p};
    hipError_t e = hipLaunchCooperativeKernel((const void*)mega_fwd, dim3(grid_blocks), dim3(NTHREADS), args, LDS_BYTES, stream);
    if (e != hipSuccess) fprintf(stderr, "cooperative launch failed: %s (grid %d)\n", hipGetErrorString(e), grid_blocks);
}
```

```cpp
#include <hip/hip_runtime.h>
#include <hip/hip_cooperative_groups.h>
#include <cstdio>
namespace cg = cooperative_groups;
namespace pg8 {
#define PG8_LAS __attribute__((address_space(3)))
typedef unsigned short bf16_t;
typedef short bf16x8 __attribute__((ext_vector_type(8)));
typedef float f32x4 __attribute__((ext_vector_type(4)));
typedef unsigned u32x4 __attribute__((ext_vector_type(4)));
constexpr int BM = 256, BK = 64, HALF = 128, HTB = HALF * BK * 2  , STAGE_BYTES = 8 * HTB, NXCD = 8, WGM = 4;

__host__ __device__ __forceinline__ int lds_byte(int r, int c) { const int st = (r >> 4) * 2 + (c >> 5), rr = r & 15, cc = c & 31, ob = rr * 64 + cc * 2; return st * 1024 + (ob ^ (((ob >> 9) & 1) << 5)); }
__host__ __device__ __forceinline__ void stage_rc(int b, int& R, int& C) { const int st = b / 1024, sb = b % 1024, swz = sb ^ (((sb >> 9) & 1) << 5); R = (st >> 1) * 16 + swz / 64; C = (st & 1) * 32 + (swz % 64) / 2; }
__host__ __device__ __forceinline__ int perm32(int rho) { const int n = rho >> 4, i = rho & 15; return 8 * (i >> 2) + 4 * n + (i & 3); }

struct Unit { int pm, pn; };
struct Gemm { const bf16_t* A; const bf16_t* Bt; int M, N, K; };

struct StaticOrder {
    int nM, nN, nwg, G, c;
    __host__ __device__ void init(int M, int N, int G_, int c_) { nM = M / BM; nN = N / BM; nwg = nM * nN; G = G_; c = c_; }
    __host__ __device__ bool next(int i, Unit& u) const {
        const long L = (long)i * G + c; if (L >= nwg) return false;
        int wgid = (int)L; { const int q = nwg / NXCD, r = nwg % NXCD, xcd = wgid % NXCD, off = wgid / NXCD; wgid = (xcd < r ? xcd * (q + 1) : r * (q + 1) + (xcd - r) * q) + off; }
        const int nig = WGM * nN, gid = wgid / nig, fm = gid * WGM, gsz = (nM - fm) < WGM ? (nM - fm) : WGM;
        u.pm = fm + ((wgid % nig) % gsz); u.pn = (wgid % nig) / gsz; return true;
    }
    __device__ __forceinline__ void a_ready(const Unit&) const {}
    __device__ __forceinline__ void done(const Unit&) const {}
};
struct RangeOrder : StaticOrder { int i0, i1;
    __host__ __device__ bool next(int i, Unit& u) const { return (i + i0 < i1) && StaticOrder::next(i + i0, u); } };
__device__ __forceinline__ unsigned cvt_pk_bf16(float lo, float hi) { typedef float f2_ __attribute__((ext_vector_type(2))); typedef __bf16 b2_ __attribute__((ext_vector_type(2))); const f2_ v = {lo, hi}; return __builtin_bit_cast(unsigned, __builtin_convertvector(v, b2_)); }
typedef float f32x2 __attribute__((ext_vector_type(2)));
typedef unsigned u32x2 __attribute__((ext_vector_type(2)));
__device__ __forceinline__ float fast_sigmoid(float x) { return __builtin_amdgcn_rcpf(1.0f + __builtin_amdgcn_exp2f(-1.4426950408889634f * x)); }

struct EpiSwiglu {
    static constexpr bool PERM = true, AFTER_DRAIN = false;
    bf16_t* H; int ldh;
    __device__ __forceinline__ void operator()(const f32x4 (&acc)[2][2][4][2], const Unit& u, int wr, int wc, int fr, int fq) const {
        const int row0 = u.pm * BM + wr * 64 + fr, col0 = u.pn * HALF + wc * 32 + 8 * fq;
#pragma unroll
        for (int ai = 0; ai < 2; ++ai)
#pragma unroll
            for (int m = 0; m < 4; ++m) {
                bf16_t* rowp = H + (size_t)(row0 + ai * HALF + m * 16) * ldh + col0;
                float h[8];
#pragma unroll
                for (int n = 0; n < 2; ++n)
#pragma unroll
                    for (int j = 0; j < 4; ++j) { const float g = acc[ai][0][m][n][j], up = acc[ai][1][m][n][j]; h[n * 4 + j] = g * fast_sigmoid(g) * up; }
                u32x4 w; w.x = cvt_pk_bf16(h[0], h[1]); w.y = cvt_pk_bf16(h[2], h[3]); w.z = cvt_pk_bf16(h[4], h[5]); w.w = cvt_pk_bf16(h[6], h[7]);
                *(u32x4*)rowp = w;
            }
    }
};
struct EpiStoreBf16 {
    static constexpr bool PERM = true, AFTER_DRAIN = false;
    bf16_t* O; int ldc; const float* cscale;
    __device__ __forceinline__ void operator()(const f32x4 (&acc)[2][2][4][2], const Unit& u, int wr, int wc, int fr, int fq) const {
        const int row0 = u.pm * BM + wr * 64 + fr, col0 = u.pn * BM + wc * 32 + 8 * fq;
        f32x4 sc[2][2];
#pragma unroll
        for (int bj = 0; bj < 2; ++bj)
#pragma unroll
            for (int n = 0; n < 2; ++n) sc[bj][n] = cscale ? *(const f32x4*)(cscale + col0 + bj * HALF + 4 * n) : (f32x4){1.f, 1.f, 1.f, 1.f};
#pragma unroll
        for (int ai = 0; ai < 2; ++ai)
#pragma unroll
            for (int m = 0; m < 4; ++m) { bf16_t* rowp = O + (size_t)(row0 + ai * HALF + m * 16) * ldc + col0;
#pragma unroll
                for (int bj = 0; bj < 2; ++bj) { const f32x4 v0 = acc[ai][bj][m][0] * sc[bj][0], v1 = acc[ai][bj][m][1] * sc[bj][1];
                    u32x4 w; w.x = cvt_pk_bf16(v0[0], v0[1]); w.y = cvt_pk_bf16(v0[2], v0[3]); w.z = cvt_pk_bf16(v1[0], v1[1]); w.w = cvt_pk_bf16(v1[2], v1[3]);
                    *(u32x4*)(rowp + bj * HALF) = w; } }
    }
};
struct EpiResidIn {
    static constexpr bool PERM = false, AFTER_DRAIN = false;
    const float* srcA; const float* srcB; int split_row; float* out; float sa, sb;
    __device__ __forceinline__ void operator()(const f32x4 (&acc)[2][2][4][2], const Unit& u, int wr, int wc, int fr, int fq) const {
        constexpr int ldc = 1024;
        const int row0 = u.pm * BM + wr * 64 + fr, col0 = u.pn * BM + wc * 32 + 4 * fq;
        const float* src = (u.pm * BM >= split_row) ? srcB : srcA;
#pragma unroll
        for (int ai = 0; ai < 2; ++ai)
#pragma unroll
            for (int m = 0; m < 4; ++m) { const size_t off = (size_t)(row0 + ai * HALF + m * 16) * ldc + col0;
#pragma unroll
                for (int bj = 0; bj < 2; ++bj)
#pragma unroll
                    for (int n = 0; n < 2; ++n) { const f32x4 s = *(const f32x4*)(src + off + bj * HALF + n * 16); *(f32x4*)(out + off + bj * HALF + n * 16) = s * sa + acc[ai][bj][m][n] * sb; }
                asm volatile("" ::: "memory"); }
    }
};
template <bool OB, bool SBHALF> struct EpiResidLN {
    static constexpr bool PERM = false, AFTER_DRAIN = false;
    float* out; bf16_t* ob; int stats_off, gb_off;
    __device__ __forceinline__ void operator()(const f32x4 (&acc)[2][2][4][2], const Unit& u, int wr, int wc, int fr, int fq) const {
        constexpr int ldc = 1024;
        const int row0 = u.pm * BM + wr * 64 + fr, col0 = u.pn * BM + wc * 32 + 4 * fq;
        float* const out = this->out; bf16_t* const ob = this->ob; const float sa = 1.4142135623730951f, sb = SBHALF ? 0.5f : 1.0f;
        const float* const stats = (const float*)((const char*)out + stats_off); const float* const gb = (const float*)((const char*)out + gb_off);
#pragma unroll
        for (int bj = 0; bj < 2; ++bj)
#pragma unroll
            for (int n = 0; n < 2; ++n) {
                const int cc = col0 + bj * HALF + n * 16;
                const f32x4 gv = *(const f32x4*)(gb + cc), bv = *(const f32x4*)(gb + 1024 + cc);
#pragma unroll
                for (int ai = 0; ai < 2; ++ai)
#pragma unroll
                    for (int m = 0; m < 4; ++m) { const int row = row0 + ai * HALF + m * 16; const unsigned off = (unsigned)row * ldc + cc;
                        const f32x4 s0 = *(const f32x4*)(out + off); const f32x2 st = *(const f32x2*)(stats + 2u * (unsigned)row);
                        const f32x4 o = ((s0 - st.x) * st.y * gv + bv) * sa + acc[ai][bj][m][n] * sb;
                        *(f32x4*)(out + off) = o;
                        if (OB) { u32x2 w; w.x = cvt_pk_bf16(o[0], o[1]); w.y = cvt_pk_bf16(o[2], o[3]); *(u32x2*)(ob + off) = w; } }
                asm volatile("" ::: "memory"); }
    }
};
struct EpiGate {
    static constexpr bool PERM = false, AFTER_DRAIN = false;
    float* R; const bf16_t* PP; const float* bias; int ldc;
    __device__ __forceinline__ void operator()(const f32x4 (&acc)[2][2][4][2], const Unit& u, int wr, int wc, int fr, int fq) const {
        const int row0 = u.pm * BM + wr * 64 + fr, col0 = u.pn * BM + wc * 32 + 4 * fq;
        f32x4 bv[2][2];
#pragma unroll
        for (int bj = 0; bj < 2; ++bj)
#pragma unroll
            for (int n = 0; n < 2; ++n) bv[bj][n] = *(const f32x4*)(bias + col0 + bj * HALF + n * 16);
#pragma unroll
        for (int ai = 0; ai < 2; ++ai)
#pragma unroll
            for (int m = 0; m < 4; ++m) { const size_t off = (size_t)(row0 + ai * HALF + m * 16) * ldc + col0;
#pragma unroll
                for (int bj = 0; bj < 2; ++bj)
#pragma unroll
                    for (int n = 0; n < 2; ++n) { const size_t o2 = off + bj * HALF + n * 16; const f32x4 s = *(const f32x4*)(R + o2); const u32x2 pw = *(const u32x2*)(PP + o2);
                        const f32x4 a = acc[ai][bj][m][n] + bv[bj][n]; f32x4 o;
                        o[0] = s[0] + fast_sigmoid(a[0]) * __uint_as_float(pw.x << 16); o[1] = s[1] + fast_sigmoid(a[1]) * __uint_as_float(pw.x & 0xffff0000u);
                        o[2] = s[2] + fast_sigmoid(a[2]) * __uint_as_float(pw.y << 16); o[3] = s[3] + fast_sigmoid(a[3]) * __uint_as_float(pw.y & 0xffff0000u);
                        *(f32x4*)(R + o2) = o; }
                asm volatile("" ::: "memory"); }
    }
};
template <class Epi, class Sched, bool STAMP = false>
__device__ __forceinline__ void gemm_phase(PG8_LAS unsigned char* lds, const Gemm g, const Sched& S, const Epi& E, unsigned long long* stamps) {
    int tid_l = threadIdx.x; asm volatile("" : "+v"(tid_l));
    const int tid = tid_l, wid = __builtin_amdgcn_readfirstlane(tid >> 6), lane = tid & 63, wr = wid >> 2, wc = wid & 3, fr = lane & 15, fq = lane >> 4;
    const int K = g.K, nt = K / BK;
    int ts_lo = 0, ts_hi = 0, nts = 0; const unsigned long long rt_entry = STAMP ? (unsigned long long)wall_clock64() : 0ull;
#define PG8_STAMP() do { if (STAMP && wid == 0 && nts < 64) { const unsigned long long _c = (unsigned long long)clock64(); \
        ts_lo = (lane == nts) ? (int)(unsigned)_c : ts_lo; ts_hi = (lane == nts) ? (int)(unsigned)(_c >> 32) : ts_hi; ++nts; } } while (0)
    PG8_STAMP();
    unsigned voffA[2], voffB[2];
#pragma unroll
    for (int i = 0; i < 2; ++i) { int R, C; stage_rc(tid * 16 + i * 8192, R, C); const int Rb = Epi::PERM ? ((R & ~31) + perm32(R & 31)) : R;
        voffA[i] = (unsigned)(R * K + C) * 2u; voffB[i] = (unsigned)(Rb * K + C) * 2u; }
    const size_t kstep = (size_t)(BK * 2);
    const size_t hstep = (size_t)HALF * K * 2;
    const size_t tstep = 2 * hstep;
    const unsigned ldsw = (unsigned)wid * 1024u;
    const int aoff = lds_byte(wr * 64 + fr, fq * 8), boff = lds_byte(wc * 32 + fr, fq * 8);
#define PG8_SA(b, h) (((b) * 2 + (h)) * HTB)
#define PG8_SB(b, h) ((4 + (b) * 2 + (h)) * HTB)
#define PG8_STAGE(bufoff, gbase, voff) do { _Pragma("unroll") for (int _i = 0; _i < 2; ++_i) \
        __builtin_amdgcn_global_load_lds((const unsigned*)((const char*)(gbase) + (voff)[_i]), (PG8_LAS unsigned*)(lds + (bufoff) + ldsw + _i * 8192), 16, 0, 0); } while (0)
#define PG8_LDA(dst, b, h) do { _Pragma("unroll") for (int m = 0; m < 4; ++m) _Pragma("unroll") for (int k = 0; k < 2; ++k) dst[m][k] = *(const PG8_LAS bf16x8*)(lds + PG8_SA(b, h) + aoff + m * 2048 + k * 1024); } while (0)
#define PG8_LDB(dst, b, h) do { _Pragma("unroll") for (int n = 0; n < 2; ++n) _Pragma("unroll") for (int k = 0; k < 2; ++k) dst[n][k] = *(const PG8_LAS bf16x8*)(lds + PG8_SB(b, h) + boff + n * 2048 + k * 1024); } while (0)
#define PG8_MMA(ai, bj, At, Bt) do { __builtin_amdgcn_s_setprio(1); _Pragma("unroll") for (int m = 0; m < 4; ++m) _Pragma("unroll") for (int n = 0; n < 2; ++n) _Pragma("unroll") for (int k = 0; k < 2; ++k) \
        acc[ai][bj][m][n] = __builtin_amdgcn_mfma_f32_16x16x32_bf16(Bt[n][k], At[m][k], acc[ai][bj][m][n], 0, 0, 0); __builtin_amdgcn_s_setprio(0); } while (0)
#define PG8_WAIT_V(n) asm volatile("s_waitcnt vmcnt(" #n ")" ::: "memory")
#define PG8_WAIT_L(n) asm volatile("s_waitcnt lgkmcnt(" #n ")" ::: "memory")
#define PG8_BAR __builtin_amdgcn_s_barrier()
#define PG8_SCHED __builtin_amdgcn_sched_barrier(0)
    Unit cur, nxt; int ui = 0;
    if (!S.next(0, cur)) return;
    f32x4 acc[2][2][4][2];
#pragma unroll
    for (int a = 0; a < 2; ++a)
#pragma unroll
        for (int b = 0; b < 2; ++b)
#pragma unroll
            for (int m = 0; m < 4; ++m)
#pragma unroll
                for (int n = 0; n < 2; ++n) acc[a][b][m][n] = (f32x4){0.f, 0.f, 0.f, 0.f};
    bf16x8 At[4][2], B0[2][2], B1[2][2];
    const char* cA = (const char*)g.A + (size_t)cur.pm * tstep; const char* cB = (const char*)g.Bt + (size_t)cur.pn * tstep;
    S.a_ready(cur);
    PG8_STAGE(PG8_SB(0, 0), cB, voffB); PG8_STAGE(PG8_SA(0, 0), cA, voffA); PG8_STAGE(PG8_SB(0, 1), cB + hstep, voffB); PG8_STAGE(PG8_SA(0, 1), cA + hstep, voffA);
    if (wr == 1) PG8_BAR;
    PG8_WAIT_V(4); PG8_BAR;
    PG8_STAGE(PG8_SB(1, 0), cB + kstep, voffB); PG8_STAGE(PG8_SA(1, 0), cA + kstep, voffA); PG8_STAGE(PG8_SB(1, 1), cB + hstep + kstep, voffB);
    PG8_WAIT_V(6); PG8_BAR;
    PG8_STAMP();
    for (;;) {
        const bool has_next = S.next(ui + 1, nxt);
        const char* nA = has_next ? (const char*)g.A + (size_t)nxt.pm * tstep : cA; const char* nB = has_next ? (const char*)g.Bt + (size_t)nxt.pn * tstep : cB;
        for (int t = 0; t < nt; t += 2) {
            const bool last = (t == nt - 2);
            const char* a1 = cA + (size_t)(t + 1) * kstep;
            const char* a2 = last ? nA : cA + (size_t)(t + 2) * kstep; const char* b2 = last ? nB : cB + (size_t)(t + 2) * kstep;
            const char* a3 = a2 + kstep; const char* b3 = b2 + kstep;
            if (last && has_next) S.a_ready(nxt);
            PG8_LDB(B0, 0, 0); PG8_SCHED; PG8_LDA(At, 0, 0); PG8_STAGE(PG8_SA(1, 1), a1 + hstep, voffA);
            PG8_WAIT_L(8); PG8_BAR; PG8_WAIT_L(0); PG8_MMA(0, 0, At, B0); PG8_BAR; PG8_SCHED;
            PG8_LDB(B1, 0, 1); PG8_STAGE(PG8_SB(0, 0), b2, voffB);
            PG8_BAR; PG8_WAIT_L(0); PG8_MMA(0, 1, At, B1); PG8_BAR;
            PG8_LDA(At, 0, 1); PG8_STAGE(PG8_SA(0, 0), a2, voffA);
            PG8_BAR; PG8_WAIT_L(0); PG8_MMA(1, 0, At, B0); PG8_BAR; PG8_SCHED;
            PG8_STAGE(PG8_SB(0, 1), b2 + hstep, voffB);
            PG8_WAIT_V(6); PG8_BAR; PG8_MMA(1, 1, At, B1); PG8_BAR;
            PG8_LDB(B0, 1, 0); PG8_SCHED; PG8_LDA(At, 1, 0); PG8_STAGE(PG8_SA(0, 1), a2 + hstep, voffA);
            PG8_WAIT_L(8); PG8_BAR; PG8_WAIT_L(0); PG8_MMA(0, 0, At, B0); PG8_BAR; PG8_SCHED;
            PG8_LDB(B1, 1, 1); PG8_STAGE(PG8_SB(1, 0), b3, voffB);
            PG8_BAR; PG8_WAIT_L(0); PG8_MMA(0, 1, At, B1); PG8_BAR;
            PG8_LDA(At, 1, 1); PG8_STAGE(PG8_SA(1, 0), a3, voffA);
            PG8_BAR; PG8_WAIT_L(0); PG8_MMA(1, 0, At, B0); PG8_BAR; PG8_SCHED;
            PG8_STAGE(PG8_SB(1, 1), b3 + hstep, voffB);
            PG8_WAIT_V(6); PG8_BAR; PG8_MMA(1, 1, At, B1); PG8_BAR;
        }
        PG8_STAMP();
        if constexpr (!Epi::AFTER_DRAIN) { E(acc, cur, wr, wc, fr, fq); S.done(cur); }
        PG8_STAMP();
        if (!has_next) break;
#pragma unroll
        for (int a = 0; a < 2; ++a)
#pragma unroll
            for (int b = 0; b < 2; ++b)
#pragma unroll
                for (int m = 0; m < 4; ++m)
#pragma unroll
                    for (int n = 0; n < 2; ++n) acc[a][b][m][n] = (f32x4){0.f, 0.f, 0.f, 0.f};
        cur = nxt; cA = nA; cB = nB; ++ui;
    }
    PG8_WAIT_V(0);
    if (wr == 0) PG8_BAR;
    PG8_BAR;
    if constexpr (Epi::AFTER_DRAIN) { E.fused(acc, cur, wr, wc, fr, fq, lds, wid, lane); S.done(cur); }
    PG8_STAMP();
    if (STAMP && wid == 0) { stamps[lane] = lane < nts ? (((unsigned long long)(unsigned)ts_hi << 32) | (unsigned)ts_lo) : 0ull;
        if (lane == 62) stamps[62] = rt_entry; if (lane == 63) stamps[63] = (unsigned long long)wall_clock64(); }
#undef PG8_STAMP
#undef PG8_SA
#undef PG8_SB
#undef PG8_STAGE
#undef PG8_LDA
#undef PG8_LDB
#undef PG8_MMA
#undef PG8_WAIT_V
#undef PG8_WAIT_L
#undef PG8_BAR
#undef PG8_SCHED
}
}

#define LAS __attribute__((address_space(3)))
typedef unsigned short bf16_t;
typedef short bf16x8 __attribute__((ext_vector_type(8)));
typedef float f32x4 __attribute__((ext_vector_type(4)));
typedef unsigned u32x4 __attribute__((ext_vector_type(4)));
typedef unsigned u32x2 __attribute__((ext_vector_type(2)));
typedef float f32x2s __attribute__((ext_vector_type(2)));

constexpr int MROWS = 66048, MP = 65536, DM = 1024, DFF = 2816, NIN = 2816, NHEAD = 12;
constexpr float ALPHA_F = 1.4142135623730951f;
constexpr int LDS_XB = 156992;
constexpr int LDS_BYTES = 157056;
constexpr int NTHREADS = 512;
constexpr size_t WT_FFN1IN = 0, WT_FFN1OUT = 5767168, WT_WIN = 8650752, WT_POOL = 11534336, WT_WOUT = 11599872, WT_FFN2IN = 12648448, WT_FFN2OUT = 18415616,
                 WT_GATE = 21299200, WT_PLE = 22347776, WT_LAYER = 22609920;
constexpr size_t OFF_WT = 0, OFF_R = 90439680, OFF_XB = 360972288, OFF_HZ = 496238592, OFF_PB = 868220928, OFF_PP = 935854080, OFF_STATS = 1071120384, OFF_GB = 1071648768, OFF_BAR = 1071697920, WS_END = 1071711744;
constexpr size_t O_YP = 0, O_YS = 67108864, O_PP = 67633152, O_SP = 67756032, O_WP = 67837952, O_PS = 69410816, O_SS = 69533696, O_WS = 69615616;

struct Params { const float* in[35]; float* out; unsigned char* ws; };

__device__ __forceinline__ float bf_lo(unsigned w) { return __uint_as_float(w << 16); }
__device__ __forceinline__ float bf_hi(unsigned w) { return __uint_as_float(w & 0xffff0000u); }
__device__ __forceinline__ unsigned short f2bf(float f) { return (unsigned short)(pg8::cvt_pk_bf16(f, 0.f) & 0xffffu); }
__device__ __forceinline__ float wave_sum(float v) {
#pragma unroll
    for (int o = 32; o >= 1; o >>= 1) v += __shfl_xor(v, o);
    return v;
}
__device__ __forceinline__ const Params& fresh_params() { auto k = __builtin_amdgcn_kernarg_segment_ptr(); asm volatile("" : "+s"(k)); return *(const Params*)k; }
__device__ __forceinline__ int fresh_tid() { int t = threadIdx.x; asm volatile("" : "+v"(t)); return t; }
template <int CTRL> __device__ __forceinline__ float dpp_mov(float v) { return __builtin_bit_cast(float, __builtin_amdgcn_update_dpp(0, __builtin_bit_cast(int, v), CTRL, 0xF, 0xF, true)); }
__device__ __forceinline__ float allreduce8(float v) { v += dpp_mov<0xB1>(v); v += dpp_mov<0x4E>(v); v += dpp_mov<0x141>(v); return v; }
__device__ __forceinline__ float fsig(float x) { return __builtin_amdgcn_rcpf(1.0f + __builtin_amdgcn_exp2f(-1.4426950408889634f * x)); }
__device__ __forceinline__ float ftanh(float x) { return 1.0f - 2.0f * __builtin_amdgcn_rcpf(1.0f + __builtin_amdgcn_exp2f(2.8853900817779268f * x)); }

__device__ void convert_weight(const float* src, int K, int Nsrc, int Nd, int mode, bf16_t* dst, LAS float* tile) {
    const int tid = fresh_tid(), ntn = Nd / 64, ntk = K / 64;
    for (int t = blockIdx.x; t < ntn * ntk; t += gridDim.x) {
        const int tn = t % ntn, tk = t / ntn, n0 = tn * 64, k0 = tk * 64;
        int c0 = n0;
        if (mode == 1) { const int pn = n0 >> 8, w = n0 & 255; c0 = (w < 128) ? (128 * pn + w) : (DFF + 128 * pn + (w - 128)); }
#pragma unroll
        for (int i = 0; i < 2; ++i) { const int kk = (tid >> 4) + 32 * i, c4 = tid & 15;
            const f32x4 v = *(const f32x4*)(src + (size_t)(k0 + kk) * Nsrc + c0 + 4 * c4);
            tile[kk * 65 + 4 * c4 + 0] = v[0]; tile[kk * 65 + 4 * c4 + 1] = v[1]; tile[kk * 65 + 4 * c4 + 2] = v[2]; tile[kk * 65 + 4 * c4 + 3] = v[3]; }
        __syncthreads();
        { const int n = tid >> 3, k8 = tid & 7; float f[8];
#pragma unroll
            for (int j = 0; j < 8; ++j) f[j] = tile[(k8 * 8 + j) * 65 + n];
            u32x4 w; w.x = pg8::cvt_pk_bf16(f[0], f[1]); w.y = pg8::cvt_pk_bf16(f[2], f[3]); w.z = pg8::cvt_pk_bf16(f[4], f[5]); w.w = pg8::cvt_pk_bf16(f[6], f[7]);
            *(u32x4*)(dst + (size_t)(n0 + n) * K + k0 + k8 * 8) = w; }
        __syncthreads();
    }
}
__device__ void prologue(LAS unsigned char* lds) {
    const Params& p = fresh_params();
    LAS float* tile = (LAS float*)lds;
    bf16_t* WT = (bf16_t*)(p.ws + OFF_WT);
    for (int l = 0; l < 2; ++l) {
        bf16_t* W = WT + (size_t)l * WT_LAYER;
        convert_weight(p.in[13] + (size_t)l * DM * 2 * DFF, DM, 2 * DFF, 2 * DFF, 1, W + WT_FFN1IN, tile);
        convert_weight(p.in[14] + (size_t)l * DFF * DM, DFF, DM, DM, 0, W + WT_FFN1OUT, tile);
        convert_weight(p.in[17] + (size_t)l * DM * NIN, DM, NIN, NIN, 0, W + WT_WIN, tile);
        convert_weight(p.in[31] + (size_t)l * DM * DM, DM, DM, DM, 0, W + WT_WOUT, tile);
        convert_weight(p.in[15] + (size_t)l * DM * 2 * DFF, DM, 2 * DFF, 2 * DFF, 1, W + WT_FFN2IN, tile);
        convert_weight(p.in[16] + (size_t)l * DFF * DM, DFF, DM, DM, 0, W + WT_FFN2OUT, tile);
        convert_weight(p.in[32] + (size_t)l * DM * DM, DM, DM, DM, 0, W + WT_GATE, tile);
        convert_weight(p.in[34] + (size_t)l * 256 * DM, 256, DM, DM, 0, W + WT_PLE, tile);
        const float* pw = p.in[19] + (size_t)l * 4 * 64 * 64;
        for (int i = blockIdx.x * NTHREADS + fresh_tid(); i < 256 * 256; i += gridDim.x * NTHREADS) {
            const int n = i >> 8, k = i & 255, g = n >> 6, d = n & 63, g2 = k >> 6, c = k & 63;
            W[WT_POOL + i] = (g == g2) ? f2bf(pw[(g * 64 + c) * 64 + d]) : (bf16_t)0;
        }
    }
    { float* GBw = (float*)(p.ws + OFF_GB);
      for (int i = blockIdx.x * NTHREADS + fresh_tid(); i < 2 * 3 * 2048; i += gridDim.x * NTHREADS) {
          const int l = i / 6144, j = (i % 6144) / 2048, e = i % 2048;
          GBw[i] = p.in[7 + 2 * j + (e >> 10)][l * DM + (e & 1023)]; } }
    bf16_t* XB = (bf16_t*)(p.ws + OFF_XB);
    const size_t gt = (size_t)blockIdx.x * NTHREADS + fresh_tid(), gs = (size_t)gridDim.x * NTHREADS;
    for (size_t i = gt; i < (size_t)MROWS * DM / 8; i += gs) {
        const size_t e = i * 8; const float* s = (e < (size_t)MP * DM) ? p.in[0] + e : p.in[1] + (e - (size_t)MP * DM);
        const f32x4 a = *(const f32x4*)s, b = *(const f32x4*)(s + 4);
        u32x4 w; w.x = pg8::cvt_pk_bf16(a[0], a[1]); w.y = pg8::cvt_pk_bf16(a[2], a[3]); w.z = pg8::cvt_pk_bf16(b[0], b[1]); w.w = pg8::cvt_pk_bf16(b[2], b[3]);
        *(u32x4*)(XB + e) = w;
    }
    bf16_t* PB = (bf16_t*)(p.ws + OFF_PB);
    for (size_t i = gt; i < (size_t)2 * MROWS * 256 / 8; i += gs) {
        const size_t e = i * 8; const int l = (int)(e / ((size_t)MROWS * 256)); const size_t r = e - (size_t)l * MROWS * 256;
        const float* s = (r < (size_t)MP * 256) ? p.in[2] + (size_t)l * MP * 256 + r : p.in[3] + (size_t)l * 512 * 256 + (r - (size_t)MP * 256);
        const f32x4 a = *(const f32x4*)s, b = *(const f32x4*)(s + 4);
        u32x4 w; w.x = pg8::cvt_pk_bf16(a[0], a[1]); w.y = pg8::cvt_pk_bf16(a[2], a[3]); w.z = pg8::cvt_pk_bf16(b[0], b[1]); w.w = pg8::cvt_pk_bf16(b[2], b[3]);
        *(u32x4*)(PB + e) = w;
    }
}

__device__ __forceinline__ void ln_row(int row, int lane, float* R, const f32x4 (&gv)[4], const f32x4 (&bv)[4], bf16_t* xb, float* outp, float* outs, float* stats) {
    float* rp = R + (size_t)row * DM;
    f32x4 v[4]; float s = 0.f;
#pragma unroll
    for (int i = 0; i < 4; ++i) { v[i] = *(const f32x4*)(rp + i * 256 + lane * 4); s += (v[i][0] + v[i][1]) + (v[i][2] + v[i][3]); }
    const float mean = wave_sum(s) * (1.0f / 1024.0f);
    float q = 0.f;
#pragma unroll
    for (int i = 0; i < 4; ++i) { v[i] = v[i] - mean; q += (v[i][0] * v[i][0] + v[i][1] * v[i][1]) + (v[i][2] * v[i][2] + v[i][3] * v[i][3]); }
    const float rstd = 1.0f / sqrtf(wave_sum(q) * (1.0f / 1024.0f) + 1e-5f);
    float* op = outp ? ((row < MP) ? outp + (size_t)row * DM : outs + (size_t)(row - MP) * DM) : rp;
    if (stats && lane == 0) *(f32x2s*)(stats + 2 * (size_t)row) = (f32x2s){mean, rstd};
#pragma unroll
    for (int i = 0; i < 4; ++i) { const f32x4 y = v[i] * rstd * gv[i] + bv[i];
        if (!stats) *(f32x4*)(op + i * 256 + lane * 4) = y;
        if (xb) { u32x2 w; w.x = pg8::cvt_pk_bf16(y[0], y[1]); w.y = pg8::cvt_pk_bf16(y[2], y[3]); *(u32x2*)(xb + (size_t)row * DM + i * 256 + lane * 4) = w; } }
}
__device__ void ln_tiles(int part, float* R, const float* g, const float* b, bf16_t* xb, float* outp, float* outs, float* stats) {
    const int tid = fresh_tid(), lane = tid & 63, wave = tid >> 6;
    int s0, s1, s2, s3, s4, s5, s6, s7;
    { pg8::StaticOrder S8; pg8::Unit u8;
      S8.init(MROWS, DM, 256, 0); S8.next(4, u8); s0 = u8.pm; S8.init(MROWS, DM, 256, 1); S8.next(4, u8); s1 = u8.pm; S8.init(MROWS, DM, 256, 2); S8.next(4, u8); s2 = u8.pm; S8.init(MROWS, DM, 256, 3); S8.next(4, u8); s3 = u8.pm;
      S8.init(MROWS, DM, 256, 4); S8.next(4, u8); s4 = u8.pm; S8.init(MROWS, DM, 256, 5); S8.next(4, u8); s5 = u8.pm; S8.init(MROWS, DM, 256, 6); S8.next(4, u8); s6 = u8.pm; S8.init(MROWS, DM, 256, 7); S8.next(4, u8); s7 = u8.pm; }
    f32x4 gv[4], bv[4];
#pragma unroll
    for (int i = 0; i < 4; ++i) { gv[i] = *(const f32x4*)(g + i * 256 + lane * 4); bv[i] = *(const f32x4*)(b + i * 256 + lane * 4); }
    if (part == 0) {
        const int wg = (int)blockIdx.x - 8, nwg = (int)gridDim.x - 8;
        for (int row = wg * 8 + wave; row < MROWS; row += nwg * 8) {
            const int t = row >> 8;
            if (t == s0 || t == s1 || t == s2 || t == s3 || t == s4 || t == s5 || t == s6 || t == s7) continue;
            ln_row(row, lane, R, gv, bv, xb, outp, outs, stats);
        }
    } else {
        for (int idx = blockIdx.x * 8 + wave; idx < 8 * 256; idx += gridDim.x * 8) {
            const int j = idx >> 8, t = j == 0 ? s0 : j == 1 ? s1 : j == 2 ? s2 : j == 3 ? s3 : j == 4 ? s4 : j == 5 ? s5 : j == 6 ? s6 : s7;
            ln_row(t * 256 + (idx & 255), lane, R, gv, bv, xb, outp, outs, stats);
        }
    }
}
__device__ void ln_phase(float* R, const float* g, const float* b, bf16_t* xb, float* outp, float* outs, float* stats) {
    const int tid = fresh_tid(), lane = tid & 63, wave = tid >> 6;
    f32x4 gv[4], bv[4];
#pragma unroll
    for (int i = 0; i < 4; ++i) { gv[i] = *(const f32x4*)(g + i * 256 + lane * 4); bv[i] = *(const f32x4*)(b + i * 256 + lane * 4); }
    for (int row = blockIdx.x * 8 + wave; row < MROWS; row += gridDim.x * 8) {
        float* rp = R + (size_t)row * DM;
        f32x4 v[4]; float s = 0.f;
#pragma unroll
        for (int i = 0; i < 4; ++i) { v[i] = *(const f32x4*)(rp + i * 256 + lane * 4); s += (v[i][0] + v[i][1]) + (v[i][2] + v[i][3]); }
        const float mean = wave_sum(s) * (1.0f / 1024.0f);
        float q = 0.f;
#pragma unroll
        for (int i = 0; i < 4; ++i) { v[i] = v[i] - mean; q += (v[i][0] * v[i][0] + v[i][1] * v[i][1]) + (v[i][2] * v[i][2] + v[i][3] * v[i][3]); }
        const float rstd = 1.0f / sqrtf(wave_sum(q) * (1.0f / 1024.0f) + 1e-5f);
        float* op = outp ? ((row < MP) ? outp + (size_t)row * DM : outs + (size_t)(row - MP) * DM) : rp;
        if (stats && lane == 0) *(f32x2s*)(stats + 2 * (size_t)row) = (f32x2s){mean, rstd};
#pragma unroll
        for (int i = 0; i < 4; ++i) { const f32x4 y = v[i] * rstd * gv[i] + bv[i];
            if (!stats) *(f32x4*)(op + i * 256 + lane * 4) = y;
            if (xb) { u32x2 w; w.x = pg8::cvt_pk_bf16(y[0], y[1]); w.y = pg8::cvt_pk_bf16(y[2], y[3]); *(u32x2*)(xb + (size_t)row * DM + i * 256 + lane * 4) = w; } }
    }
}

__device__ void mixprep_phase(int l, const bf16_t* Z, bf16_t* pooled, bf16_t* lora_a) {
    const Params& p = fresh_params();
    const size_t gt = (size_t)blockIdx.x * NTHREADS + fresh_tid(), gs = (size_t)gridDim.x * NTHREADS;
    const float* hist_all = p.in[4] + (size_t)l * 16 * 15 * 256;
    for (size_t task = gt; task < (size_t)MROWS * 32; task += gs) {
        const int row = (int)(task >> 5), c8 = (int)(task & 31), col = c8 * 8, w = 2 << (c8 >> 3);
        const bool samp = row >= MP; const int b = samp ? ((row - MP) >> 5) : (row >> 12), t = samp ? ((row - MP) & 31) : (row & 4095);
        float acc[8], u0[8];
#pragma unroll
        for (int j = 0; j < 8; ++j) acc[j] = 0.f;
        for (int d = 0; d < w; ++d) {
            const int tt = t - d;
            if (tt >= 0) { const u32x4 q = *(const u32x4*)(Z + (size_t)(row - d) * NIN + col);
                const float f0 = bf_lo(q.x), f1 = bf_hi(q.x), f2 = bf_lo(q.y), f3 = bf_hi(q.y), f4 = bf_lo(q.z), f5 = bf_hi(q.z), f6 = bf_lo(q.w), f7 = bf_hi(q.w);
                if (d == 0) { u0[0] = f0; u0[1] = f1; u0[2] = f2; u0[3] = f3; u0[4] = f4; u0[5] = f5; u0[6] = f6; u0[7] = f7; }
                acc[0] += f0; acc[1] += f1; acc[2] += f2; acc[3] += f3; acc[4] += f4; acc[5] += f5; acc[6] += f6; acc[7] += f7; }
            else if (samp) { const float* hp = hist_all + ((size_t)b * 15 + (15 + tt)) * 256 + col; const f32x4 a = *(const f32x4*)hp, c = *(const f32x4*)(hp + 4);
                acc[0] += a[0]; acc[1] += a[1]; acc[2] += a[2]; acc[3] += a[3]; acc[4] += c[0]; acc[5] += c[1]; acc[6] += c[2]; acc[7] += c[3]; }
        }
        const float inv = 1.0f / (float)(samp ? w : ((t + 1 < w) ? (t + 1) : w));
        u32x4 o; o.x = pg8::cvt_pk_bf16(acc[0] * inv - u0[0], acc[1] * inv - u0[1]); o.y = pg8::cvt_pk_bf16(acc[2] * inv - u0[2], acc[3] * inv - u0[3]);
        o.z = pg8::cvt_pk_bf16(acc[4] * inv - u0[4], acc[5] * inv - u0[5]); o.w = pg8::cvt_pk_bf16(acc[6] * inv - u0[6], acc[7] * inv - u0[7]);
        *(u32x4*)(pooled + (size_t)row * 256 + col) = o;
        const int T = samp ? 32 : 4096;
        if (t >= T - 15) { float* op = p.out + (samp ? O_PS : O_PP) + (((size_t)l * 16 + b) * 15 + (t - (T - 15))) * 256 + col;
            *(f32x4*)op = (f32x4){u0[0], u0[1], u0[2], u0[3]}; *(f32x4*)(op + 4) = (f32x4){u0[4], u0[5], u0[6], u0[7]}; }
    }
    {
        const float* mu = p.in[18] + (size_t)l * 2560 + 2304;
        for (size_t task = gt; task < (size_t)MROWS * 32; task += gs) {
            const int row = (int)(task >> 5), q8 = (int)(task & 31), col = q8 * 8;
            const bool samp = row >= MP; const int b = samp ? ((row - MP) >> 5) : (row >> 12), t = samp ? ((row - MP) & 31) : (row & 4095);
            const u32x4 q = *(const u32x4*)(Z + (size_t)row * NIN + 256 + 2304 + col);
            float cur[8] = {bf_lo(q.x), bf_hi(q.x), bf_lo(q.y), bf_hi(q.y), bf_lo(q.z), bf_hi(q.z), bf_lo(q.w), bf_hi(q.w)};
            float prv[8];
            if (t > 0) { const u32x4 r = *(const u32x4*)(Z + (size_t)(row - 1) * NIN + 256 + 2304 + col);
                prv[0] = bf_lo(r.x); prv[1] = bf_hi(r.x); prv[2] = bf_lo(r.y); prv[3] = bf_hi(r.y); prv[4] = bf_lo(r.z); prv[5] = bf_hi(r.z); prv[6] = bf_lo(r.w); prv[7] = bf_hi(r.w); }
            else if (samp) { const float* sp = p.in[5] + ((size_t)l * 16 + b) * 2560 + 2304 + col; const f32x4 x = *(const f32x4*)sp, y = *(const f32x4*)(sp + 4);
                prv[0] = x[0]; prv[1] = x[1]; prv[2] = x[2]; prv[3] = x[3]; prv[4] = y[0]; prv[5] = y[1]; prv[6] = y[2]; prv[7] = y[3]; }
            else {
#pragma unroll
                for (int j = 0; j < 8; ++j) prv[j] = 0.f; }
            const f32x4 m0 = *(const f32x4*)(mu + col), m1 = *(const f32x4*)(mu + col + 4);
            float zs[8];
#pragma unroll
            for (int j = 0; j < 8; ++j) { zs[j] = cur[j] + (prv[j] - cur[j]) * (j < 4 ? m0[j] : m1[j - 4]); }
            if (q8 < 8) {
#pragma unroll
                for (int j = 0; j < 8; ++j) zs[j] = ftanh(zs[j]); }
            else if (q8 >= 16) {
#pragma unroll
                for (int j = 0; j < 8; ++j) zs[j] = fsig(zs[j]); }
            u32x4 w; w.x = pg8::cvt_pk_bf16(zs[0], zs[1]); w.y = pg8::cvt_pk_bf16(zs[2], zs[3]); w.z = pg8::cvt_pk_bf16(zs[4], zs[5]); w.w = pg8::cvt_pk_bf16(zs[6], zs[7]);
            *(u32x4*)(lora_a + (size_t)row * 256 + col) = w;
        }
    }
    for (size_t i = gt; i < (size_t)32 * 2560; i += gs) {
        const int s = (int)(i / 2560), c = (int)(i % 2560); const bool samp = s >= 16; const int b = s & 15;
        const int row = samp ? (MP + b * 32 + 31) : (b * 4096 + 4095);
        p.out[(samp ? O_SS : O_SP) + ((size_t)l * 16 + b) * 2560 + c] = __uint_as_float((unsigned)Z[(size_t)row * NIN + 256 + c] << 16);
    }
}

constexpr int TC = 16;
constexpr int RS = 68;
constexpr int MS = 20;
constexpr int NBUF = 4;
constexpr int B_R = 0, B_K = 4352, B_V = 8704, B_A = 13056, B_B = 17408, B_G = 21760, B_Y = 25856, B_PC = 29952, B_BON = 30208, BUFSZ = 30272;
constexpr int SC_W2 = 121088, SC_A2 = 130304, SC_G2 = 139520, SC_CTR = 156928;
constexpr int XS = 72, XGS = 136;
typedef float f32x2 __attribute__((ext_vector_type(2)));
__device__ __forceinline__ float rowsum16(float v) { v += dpp_mov<0xB1>(v); v += dpp_mov<0x4E>(v); v += dpp_mov<0x141>(v); v += dpp_mov<0x140>(v); return v; }
template <int CTRL> __device__ __forceinline__ float dpp_shr1(float v) { return __builtin_bit_cast(float, __builtin_amdgcn_update_dpp(0x3f800000, __builtin_bit_cast(int, v), CTRL, 0xF, 0xF, false)); }
__device__ __forceinline__ float rowprefix_mul(float p) { p *= dpp_shr1<0x111>(p); p *= dpp_shr1<0x112>(p); p *= dpp_shr1<0x114>(p); p *= dpp_shr1<0x118>(p); return p; }
__device__ __forceinline__ void lds_wait_ge(LAS unsigned* ctr, unsigned want) {
    while (__hip_atomic_load(ctr, __ATOMIC_ACQUIRE, __HIP_MEMORY_SCOPE_WORKGROUP) < want) {}
}
__device__ __forceinline__ void prep_bar(LAS unsigned* ctr, unsigned& gen, int lane) {
    gen += 4u;
    if (lane == 0) __hip_atomic_fetch_add(ctr, 1u, __ATOMIC_RELEASE, __HIP_MEMORY_SCOPE_WORKGROUP);
    while (__hip_atomic_load(ctr, __ATOMIC_ACQUIRE, __HIP_MEMORY_SCOPE_WORKGROUP) < gen) {}
}
#define MFMA4(a, b, c) __builtin_amdgcn_mfma_f32_16x16x4f32((a), (b), (c), 0, 0, 0)
#define MFMAB(a, b, c) __builtin_amdgcn_mfma_f32_16x16x32_bf16((a), (b), (c), 0, 0, 0)
__device__ __forceinline__ bf16x8 cvt4z(f32x4 lo) { u32x4 w; w.x = pg8::cvt_pk_bf16(lo[0], lo[1]); w.y = pg8::cvt_pk_bf16(lo[2], lo[3]); w.z = 0u; w.w = 0u; return __builtin_bit_cast(bf16x8, w); }
__device__ __forceinline__ bf16x8 cvt8(f32x4 lo, f32x4 hi) { u32x4 w; w.x = pg8::cvt_pk_bf16(lo[0], lo[1]); w.y = pg8::cvt_pk_bf16(lo[2], lo[3]); w.z = pg8::cvt_pk_bf16(hi[0], hi[1]); w.w = pg8::cvt_pk_bf16(hi[2], hi[3]); return __builtin_bit_cast(bf16x8, w); }

__device__ void scan_phase(int l, const bf16_t* Z, const bf16_t* lora_a, bf16_t* mixin, LAS unsigned char* lds) {
    const Params& p = fresh_params();
    const int tid = fresh_tid(), lane = tid & 63, wave = __builtin_amdgcn_readfirstlane(tid >> 6);
    LAS bf16_t* w2t = (LAS bf16_t*)(lds + SC_W2); LAS bf16_t* a2t = (LAS bf16_t*)(lds + SC_A2); LAS bf16_t* g2t = (LAS bf16_t*)(lds + SC_G2);
    LAS unsigned* ctr = (LAS unsigned*)(lds + SC_CTR);
    const float* mu = p.in[18] + (size_t)l * 2560;
    const int fr = lane & 15, fq = lane >> 4;
    for (int unit = blockIdx.x; unit < 384; unit += gridDim.x) {
        const bool samp = unit >= 192; const int uu = samp ? unit - 192 : unit, b = uu / 12, h = uu % 12;
        const int T = samp ? 32 : 4096, row0 = samp ? (MP + b * 32) : (b * 4096), NC = T / TC;
        __syncthreads();
        for (int i = tid; i < 64 * 64; i += NTHREADS) { const int k = i >> 6, n = i & 63;
            w2t[n * XS + k] = f2bf(p.in[22][((size_t)l * 64 + k) * 768 + h * 64 + n]);
            a2t[n * XS + k] = f2bf(p.in[24][((size_t)l * 64 + k) * 768 + h * 64 + n]); }
        for (int i = tid; i < 128 * 64; i += NTHREADS) { const int k = i >> 6, n = i & 63;
            g2t[n * XGS + k] = f2bf(p.in[25][((size_t)l * 128 + k) * 768 + h * 64 + n]); }
        if (tid < 8) ctr[tid] = 0u;
        __syncthreads();
        if (wave < 4) {
            const int vt = wave;
            f32x4 H0, H1, H2, H3;
            const size_t sbase = ((((size_t)l * 16 + b) * 12 + h) * 64 + vt * 16 + fr) * 64 + 4 * fq;
            if (samp) { const float* sp = p.in[6] + sbase; H0 = *(const f32x4*)sp; H1 = *(const f32x4*)(sp + 16); H2 = *(const f32x4*)(sp + 32); H3 = *(const f32x4*)(sp + 48); }
            else { H0 = (f32x4){0.f, 0.f, 0.f, 0.f}; H1 = H0; H2 = H0; H3 = H0; }
            asm volatile("" : "+v"(H0), "+v"(H1), "+v"(H2), "+v"(H3));
#pragma unroll 1
            for (int c = 0; c < NC; ++c) {
                const int bi = c % NBUF;
                lds_wait_ge(ctr + bi, (unsigned)(c + 1));
                LAS unsigned char* bb = lds + bi * BUFSZ;
                const LAS float* opR = (const LAS float*)(bb + B_R); const LAS float* opK = (const LAS float*)(bb + B_K); const LAS float* opV = (const LAS float*)(bb + B_V);
                const LAS float* opA = (const LAS float*)(bb + B_A); const LAS float* opB = (const LAS float*)(bb + B_B); LAS float* yB = (LAS float*)(bb + B_Y);
                const int ro = fr * RS + 4 * fq;
                const f32x4 a0 = *(const LAS f32x4*)(opA + ro), a1 = *(const LAS f32x4*)(opA + ro + 16), a2 = *(const LAS f32x4*)(opA + ro + 32), a3 = *(const LAS f32x4*)(opA + ro + 48);
                const f32x4 r0 = *(const LAS f32x4*)(opR + ro), r1 = *(const LAS f32x4*)(opR + ro + 16), r2 = *(const LAS f32x4*)(opR + ro + 32), r3 = *(const LAS f32x4*)(opR + ro + 48);
                const f32x4 b0 = *(const LAS f32x4*)(opB + ro), b1 = *(const LAS f32x4*)(opB + ro + 16), b2 = *(const LAS f32x4*)(opB + ro + 32), b3 = *(const LAS f32x4*)(opB + ro + 48);
                const f32x4 k0 = *(const LAS f32x4*)(opK + ro), k1 = *(const LAS f32x4*)(opK + ro + 16), k2 = *(const LAS f32x4*)(opK + ro + 32), k3 = *(const LAS f32x4*)(opK + ro + 48);
                f32x4 W = {0.f, 0.f, 0.f, 0.f}, Y = W;
                f32x4 LA = W, LD = W, KA = W, NbA = W, NkA = W;
                { const bf16x8 hb0 = cvt8(H0, H1), hb1 = cvt8(H2, H3);
                    const bf16x8 fa0 = cvt8(a0, a1), fa1 = cvt8(a2, a3), fr0 = cvt8(r0, r1), fr1 = cvt8(r2, r3);
                    const bf16x8 fb0 = cvt8(b0, b1), fb1 = cvt8(b2, b3), fk0 = cvt8(k0, k1), fk1 = cvt8(k2, k3);
                    W = MFMAB(fa0, hb0, W); W = MFMAB(fa1, hb1, W);
                    Y = MFMAB(fr0, hb0, Y); Y = MFMAB(fr1, hb1, Y);
                    LA = MFMAB(fb0, fa0, LA); LA = MFMAB(fb1, fa1, LA);
                    LD = MFMAB(fa0, fb0, LD); LD = MFMAB(fa1, fb1, LD);
                    KA = MFMAB(fk0, fa0, KA); KA = MFMAB(fk1, fa1, KA);
                    NbA = MFMAB(fb0, fr0, NbA); NbA = MFMAB(fb1, fr1, NbA);
                    NkA = MFMAB(fk0, fr0, NkA); NkA = MFMAB(fk1, fr1, NkA);
                }
#pragma unroll
                for (int j = 0; j < 4; ++j) { const int sA = 4 * fq + j;
                    LA[j] = (sA < fr) ? LA[j] : 0.f; KA[j] = (sA < fr) ? KA[j] : 0.f; NbA[j] = (sA <= fr) ? NbA[j] : 0.f; NkA[j] = (sA <= fr) ? NkA[j] : 0.f;
                    LD[j] = (fr < sA) ? LD[j] : 0.f; }
                const f32x4 Z4 = {0.f, 0.f, 0.f, 0.f};
                const bf16x8 fLA = cvt4z(LA), fLD = cvt4z(LD);
                const f32x4 L2A = MFMAB(fLD, fLA, Z4), L2D = MFMAB(fLA, fLD, Z4);
                const bf16x8 fL2A = cvt4z(L2A), fL2D = cvt4z(L2D);
                const f32x4 L4A = MFMAB(fL2D, fL2A, Z4), L4D = MFMAB(fL2A, fL2D, Z4);
                const bf16x8 fL4A = cvt4z(L4A), fL4D = cvt4z(L4D);
                const f32x4 L8A = MFMAB(fL4D, fL4A, Z4);
                f32x4 Vr;
#pragma unroll
                for (int j = 0; j < 4; ++j) Vr[j] = opV[(4 * fq + j) * RS + vt * 16 + fr];
                W = MFMAB(cvt4z(KA), cvt4z(Vr), W);
                W = MFMAB(fLA, cvt4z(W), W);
                W = MFMAB(fL2A, cvt4z(W), W);
                W = MFMAB(fL4A, cvt4z(W), W);
                W = MFMAB(cvt4z(L8A), cvt4z(W), W);
                const bf16x8 uvb = cvt8(W, Vr);
                Y = MFMAB(cvt8(NbA, NkA), uvb, Y);
#pragma unroll
                for (int j = 0; j < 4; ++j) yB[(4 * fq + j) * 64 + vt * 16 + fr] = Y[j];
                {
                    f32x4 bq0, bq1, bq2, bq3, kq0, kq1, kq2, kq3;
#pragma unroll
                    for (int j = 0; j < 4; ++j) { const int o = (4 * fq + j) * RS + fr;
                        bq0[j] = opB[o]; bq1[j] = opB[o + 16]; bq2[j] = opB[o + 32]; bq3[j] = opB[o + 48];
                        kq0[j] = opK[o]; kq1[j] = opK[o + 16]; kq2[j] = opK[o + 32]; kq3[j] = opK[o + 48]; }
                    H0 = MFMAB(cvt8(bq0, kq0), uvb, H0); H1 = MFMAB(cvt8(bq1, kq1), uvb, H1); H2 = MFMAB(cvt8(bq2, kq2), uvb, H2); H3 = MFMAB(cvt8(bq3, kq3), uvb, H3);
                }
                { const LAS float* pc = (const LAS float*)(bb + B_PC) + 4 * fq;
                    H0 = H0 * *(const LAS f32x4*)pc; H1 = H1 * *(const LAS f32x4*)(pc + 16); H2 = H2 * *(const LAS f32x4*)(pc + 32); H3 = H3 * *(const LAS f32x4*)(pc + 48); }
                if (lane == 0) __hip_atomic_store(ctr + 4 + vt, (unsigned)(c + 1), __ATOMIC_RELEASE, __HIP_MEMORY_SCOPE_WORKGROUP);
            }
            { float* sp = p.out + (samp ? O_WS : O_WP) + sbase; *(f32x4*)sp = H0; *(f32x4*)(sp + 16) = H1; *(f32x4*)(sp + 32) = H2; *(f32x4*)(sp + 48) = H3; }
        } else {
            const int pw = wave - 4;
            __builtin_amdgcn_s_setprio(2);
            const int ecg = lane & 15;
            const int hc4 = l * 768 + h * 64 + 4 * ecg;
            const f32x4 c_kk = *(const f32x4*)(p.in[26] + hc4), c_ka = *(const f32x4*)(p.in[27] + hc4), c_rk = *(const f32x4*)(p.in[28] + hc4);
            const f32x4 c_lg = *(const f32x4*)(p.in[29] + hc4), c_lb = *(const f32x4*)(p.in[30] + hc4);
            f32x4 cw0, ca0;
#pragma unroll
            for (int nt = 0; nt < 4; ++nt) { cw0[nt] = p.in[21][l * 768 + h * 64 + nt * 16 + fr]; ca0[nt] = p.in[23][l * 768 + h * 64 + nt * 16 + fr]; }
            const int cc = lane;
            const bool act1 = cc < 24;
            const int zc = ((act1 ? cc : 23) >> 3) * 768 + h * 64 + (cc & 7) * 8;
            const f32x4 m0 = *(const f32x4*)(mu + zc), m1 = *(const f32x4*)(mu + zc + 4);
            const bf16_t* zbase = Z + (size_t)row0 * NIN + 256 + zc;
            LAS unsigned char* bb = lds + pw * BUFSZ;
            LAS float* opR = (LAS float*)(bb + B_R); LAS float* opK = (LAS float*)(bb + B_K); LAS float* opV = (LAS float*)(bb + B_V);
            LAS float* opA = (LAS float*)(bb + B_A); LAS float* opB = (LAS float*)(bb + B_B); LAS float* gV = (LAS float*)(bb + B_G); LAS float* aL = (LAS float*)(bb + B_Y);
#define LDS_FENCE() asm volatile("s_waitcnt lgkmcnt(0)" ::: "memory")
            f32x4 pv0 = {0.f, 0.f, 0.f, 0.f}, pv1 = pv0;
            if (samp) { const float* sp = p.in[5] + ((size_t)l * 16 + b) * 2560 + zc; pv0 = *(const f32x4*)sp; pv1 = *(const f32x4*)(sp + 4); }
            asm volatile("" : "+v"(pv0), "+v"(pv1));
            u32x4 qq[16], qprev = {0u, 0u, 0u, 0u};
#pragma unroll
            for (int i = 0; i < 16; ++i) qq[i] = qprev;
            { const int c0 = pw < NC ? pw : NC - 1; const bf16_t* zp = zbase + (size_t)(c0 * TC) * NIN;
                qprev = *(const u32x4*)(zp - (c0 > 0 ? NIN : 0));
#pragma unroll
                for (int i = 0; i < 16; ++i) qq[i] = *(const u32x4*)(zp + (size_t)i * NIN); }
#pragma unroll 1
            for (int c = pw; c < NC + NBUF; c += NBUF) {
                if (c >= NBUF) {
                    { const unsigned want = (unsigned)(c - NBUF + 1); lds_wait_ge(ctr + 4, want); lds_wait_ge(ctr + 5, want); lds_wait_ge(ctr + 6, want); lds_wait_ge(ctr + 7, want); }
#pragma unroll 1
                    for (int it = 0; it < 4; ++it) {
                        const int etl = 4 * it + (lane >> 4), o = etl * 64 + 4 * ecg;
                        const f32x4 y = *(const LAS f32x4*)((LAS float*)(bb + B_Y) + o), v = *(const LAS f32x4*)(opV + etl * RS + 4 * ecg), g = *(const LAS f32x4*)(gV + o);
                        const float mean = rowsum16((y[0] + y[1]) + (y[2] + y[3])) * (1.0f / 64.0f);
                        const f32x4 d = y - mean;
                        const float var = rowsum16((d[0] * d[0] + d[1] * d[1]) + (d[2] * d[2] + d[3] * d[3])) * (1.0f / 64.0f);
                        const f32x4 ov = (d * (1.0f / sqrtf(var + 64e-5f)) * c_lg + c_lb + ((LAS float*)(bb + B_BON))[etl] * v) * g;
                        u32x2 w; w.x = pg8::cvt_pk_bf16(ov[0], ov[1]); w.y = pg8::cvt_pk_bf16(ov[2], ov[3]);
                        *(u32x2*)(mixin + ((size_t)row0 + (c - NBUF) * TC + etl) * DM + 256 + h * 64 + 4 * ecg) = w;
                    }
                    LDS_FENCE();
                }
                if (c < NC) {
                const bf16_t* lp = lora_a + ((size_t)row0 + (size_t)c * TC + fr) * 256 + fq * 8;
                const bf16x8 xw0 = *(const bf16x8*)(lp), xw1 = *(const bf16x8*)(lp + 32), xl0 = *(const bf16x8*)(lp + 64), xl1 = *(const bf16x8*)(lp + 96);
                const bf16x8 xg0 = *(const bf16x8*)(lp + 128), xg1 = *(const bf16x8*)(lp + 160), xg2 = *(const bf16x8*)(lp + 192), xg3 = *(const bf16x8*)(lp + 224);
                if (act1) {
                    float prv[8];
                    if (c > 0) { const u32x4 q = qprev;
                        prv[0] = bf_lo(q.x); prv[1] = bf_hi(q.x); prv[2] = bf_lo(q.y); prv[3] = bf_hi(q.y); prv[4] = bf_lo(q.z); prv[5] = bf_hi(q.z); prv[6] = bf_lo(q.w); prv[7] = bf_hi(q.w); }
                    else { prv[0] = pv0[0]; prv[1] = pv0[1]; prv[2] = pv0[2]; prv[3] = pv0[3]; prv[4] = pv1[0]; prv[5] = pv1[1]; prv[6] = pv1[2]; prv[7] = pv1[3]; }
                    LAS float* dst0 = (cc < 8 ? opR : (cc < 16 ? opK : opV)) + (cc & 7) * 8;
#pragma unroll
                    for (int i = 0; i < 16; ++i) {
                        const u32x4 q = qq[i];
                        float cur[8] = {bf_lo(q.x), bf_hi(q.x), bf_lo(q.y), bf_hi(q.y), bf_lo(q.z), bf_hi(q.z), bf_lo(q.w), bf_hi(q.w)};
                        float zs[8];
#pragma unroll
                        for (int j = 0; j < 8; ++j) { zs[j] = cur[j] + (prv[j] - cur[j]) * (j < 4 ? m0[j] : m1[j - 4]); prv[j] = cur[j]; }
                        *(LAS f32x4*)(dst0 + i * RS) = (f32x4){zs[0], zs[1], zs[2], zs[3]}; *(LAS f32x4*)(dst0 + i * RS + 4) = (f32x4){zs[4], zs[5], zs[6], zs[7]};
                    }
                }
                { const int cn = (c + NBUF < NC) ? c + NBUF : NC - 1; const bf16_t* zp = zbase + (size_t)(cn * TC) * NIN;
                    qprev = *(const u32x4*)(zp - (cn > 0 ? NIN : 0));
#pragma unroll
                    for (int i = 0; i < 16; ++i) qq[i] = *(const u32x4*)(zp + (size_t)i * NIN); }
                LDS_FENCE();
#pragma unroll 1
                for (int nt = 0; nt < 4; ++nt) {
                    f32x4 dw = {0.f, 0.f, 0.f, 0.f}, da = dw, dg = dw;
                    { const LAS bf16_t* wp = w2t + (nt * 16 + fr) * XS + fq * 8; const LAS bf16_t* ap = a2t + (nt * 16 + fr) * XS + fq * 8; const LAS bf16_t* gp = g2t + (nt * 16 + fr) * XGS + fq * 8;
                        dw = __builtin_amdgcn_mfma_f32_16x16x32_bf16(xw0, *(const LAS bf16x8*)wp, dw, 0, 0, 0); dw = __builtin_amdgcn_mfma_f32_16x16x32_bf16(xw1, *(const LAS bf16x8*)(wp + 32), dw, 0, 0, 0);
                        da = __builtin_amdgcn_mfma_f32_16x16x32_bf16(xl0, *(const LAS bf16x8*)ap, da, 0, 0, 0); da = __builtin_amdgcn_mfma_f32_16x16x32_bf16(xl1, *(const LAS bf16x8*)(ap + 32), da, 0, 0, 0);
                        dg = __builtin_amdgcn_mfma_f32_16x16x32_bf16(xg0, *(const LAS bf16x8*)gp, dg, 0, 0, 0); dg = __builtin_amdgcn_mfma_f32_16x16x32_bf16(xg1, *(const LAS bf16x8*)(gp + 32), dg, 0, 0, 0);
                        dg = __builtin_amdgcn_mfma_f32_16x16x32_bf16(xg2, *(const LAS bf16x8*)(gp + 64), dg, 0, 0, 0); dg = __builtin_amdgcn_mfma_f32_16x16x32_bf16(xg3, *(const LAS bf16x8*)(gp + 96), dg, 0, 0, 0); }
                    const float w0n = nt == 0 ? cw0[0] : nt == 1 ? cw0[1] : nt == 2 ? cw0[2] : cw0[3], a0n = nt == 0 ? ca0[0] : nt == 1 ? ca0[1] : nt == 2 ? ca0[2] : ca0[3];
                    f32x4 e, E = {0.f, 0.f, 0.f, 0.f};
#pragma unroll
                    for (int j = 0; j < 4; ++j) e[j] = -0.8750402888f * fsig(w0n + dw[j]);
#pragma unroll
                    for (int j = 0; j < 4; ++j) E = MFMA4((4 * fq + j <= fr) ? 1.0f : 0.0f, e[j], E);
#pragma unroll
                    for (int j = 0; j < 4; ++j) { const int t = 4 * fq + j, n = nt * 16 + fr;
                        const float P = __builtin_amdgcn_exp2f(E[j]);
                        opB[t * RS + n] = P; opA[t * RS + n] = __builtin_amdgcn_exp2f(E[j] - e[j]);
                        if (t == 15) ((LAS float*)(bb + B_PC))[n] = P;
                        aL[t * 64 + n] = fsig(a0n + da[j]); gV[t * 64 + n] = dg[j]; }
                }
                LDS_FENCE();
#pragma unroll 1
                for (int it = 0; it < 4; ++it) {
                    const int etl = 4 * it + (lane >> 4), o = etl * RS + 4 * ecg;
                    const f32x4 kr = *(const LAS f32x4*)(opK + o), a = *(const LAS f32x4*)(aL + etl * 64 + 4 * ecg), r = *(const LAS f32x4*)(opR + o);
                    const f32x4 P = *(const LAS f32x4*)(opB + o), Pex = *(const LAS f32x4*)(opA + o);
                    f32x4 kk = kr * c_kk;
                    const float nn = rowsum16((kk[0] * kk[0] + kk[1] * kk[1]) + (kk[2] * kk[2] + kk[3] * kk[3]));
                    kk = kk * (1.0f / fmaxf(sqrtf(nn), 1e-12f));
                    const f32x4 kp = kr * (1.0f + (a - 1.0f) * c_ka);
                    f32x4 inv;
#pragma unroll
                    for (int j = 0; j < 4; ++j) inv[j] = __builtin_amdgcn_rcpf(P[j]);
                    *(LAS f32x4*)(opK + o) = kp * inv; *(LAS f32x4*)(opA + o) = -kk * Pex; *(LAS f32x4*)(opB + o) = kk * a * inv; *(LAS f32x4*)(opR + o) = r * P;
                    const f32x4 rb = r * kp * c_rk;
                    const float bs = rowsum16((rb[0] + rb[1]) + (rb[2] + rb[3]));
                    if (ecg == 0) ((LAS float*)(bb + B_BON))[etl] = bs;
                }
                LDS_FENCE();
                LDS_FENCE();
                if (lane == 0) __hip_atomic_store(ctr + pw, (unsigned)(c + 1), __ATOMIC_RELEASE, __HIP_MEMORY_SCOPE_WORKGROUP);
                }
            }
            __builtin_amdgcn_s_setprio(0);
        }
#undef LDS_FENCE
    }
    __syncthreads();
}
#undef MFMA4

#define XB_TMO      128
#define XB_XCNT(j)  (256  + 64 * (j))
#define XB_XSUB(j)  (1280 + 64 * (j))
#define XB_XGEN(j)  (2304 + 64 * (j))
#define XB_TOP      3328
#define XB_TOPGEN   3392
#define XCD_BAR_WORDS 3456
#define XB_SPIN_CAP (1u << 18)

__device__ __forceinline__ unsigned xb_ld(unsigned* p)              { return __hip_atomic_load(p, __ATOMIC_RELAXED, __HIP_MEMORY_SCOPE_AGENT); }
__device__ __forceinline__ unsigned xb_add(unsigned* p, unsigned v) { return __hip_atomic_fetch_add(p, v, __ATOMIC_RELAXED, __HIP_MEMORY_SCOPE_AGENT); }
__device__ __forceinline__ unsigned xb_xcc_id() { return (unsigned)__builtin_amdgcn_s_getreg((3 << 11) | 20) & 0xFu; }
#define XB_SPIN(cond, bar) do { unsigned _sp = 0; while (cond) { __builtin_amdgcn_s_sleep(1); \
    if ((++_sp & 255u) == 0u) { if (xb_ld(&(bar)[XB_TMO])) break; if (_sp > XB_SPIN_CAP) { atomicAdd(&(bar)[XB_TMO], 1u); break; } } } } while (0)

struct XcdBarrier {
    unsigned* bar; unsigned x;
    volatile LAS unsigned* st;
};

__device__ __forceinline__ XcdBarrier xcd_barrier_post(unsigned* bar, volatile LAS unsigned* st) {
    XcdBarrier b; b.bar = bar; b.x = xb_xcc_id(); b.st = st;
    if (threadIdx.x == 0) (void)xb_add(&bar[XB_XCNT(b.x)], 1u);
    return b;
}
__device__ __forceinline__ void xcd_barrier_complete(unsigned* bar, unsigned x, unsigned& nloc, unsigned& nx) {
    const unsigned G = gridDim.x * gridDim.y * gridDim.z;
    unsigned sum, cnt, mine, sp = 0u;
    for (;;) {
        sum = 0u; cnt = 0u; mine = 0u;
#pragma unroll
        for (unsigned j = 0; j < 16; ++j) { const unsigned c = xb_ld(&bar[XB_XCNT(j)]); sum += c; cnt += (c > 0u) ? 1u : 0u; mine = (j == x) ? c : mine; }
        if (sum == G) break;
        __builtin_amdgcn_s_sleep(1);
        if ((++sp & 255u) == 0u) { if (xb_ld(&bar[XB_TMO])) break; if (sp > XB_SPIN_CAP) { atomicAdd(&bar[XB_TMO], 1u); break; } }
    }
    nloc = mine > 0u ? mine : 1u; nx = cnt > 0u ? cnt : 1u;
}

__device__ __forceinline__ void xcd_barrier(const XcdBarrier& b) {
    asm volatile("s_waitcnt vmcnt(0)" ::: "memory");
    __syncthreads();
    if (threadIdx.x == 0) {
        unsigned* bar = b.bar;
        __builtin_amdgcn_s_waitcnt(0);
        unsigned nloc = b.st[0], nx = b.st[1];
        if (nloc == 0u) { xcd_barrier_complete(bar, b.x, nloc, nx); b.st[0] = nloc; b.st[1] = nx; }
        const unsigned old = xb_add(&bar[XB_XSUB(b.x)], 1u);
        const unsigned gen = old / nloc;
        if (old + 1u == (gen + 1u) * nloc) {
            __builtin_amdgcn_fence(__ATOMIC_RELEASE, "agent");
            asm volatile("s_waitcnt vmcnt(0)" ::: "memory");
            const unsigned og = xb_add(&bar[XB_TOP], 1u);
            const unsigned tg = og / nx;
            if (og + 1u == (tg + 1u) * nx) xb_add(&bar[XB_TOPGEN], 1u);
            else XB_SPIN(xb_ld(&bar[XB_TOPGEN]) == tg, bar);
            __builtin_amdgcn_fence(__ATOMIC_ACQUIRE, "agent");
            xb_add(&bar[XB_XGEN(b.x)], 1u);
            asm volatile("s_waitcnt vmcnt(0)" ::: "memory");
        } else {
            XB_SPIN(xb_ld(&bar[XB_XGEN(b.x)]) == gen, bar);
            __builtin_amdgcn_fence(__ATOMIC_ACQUIRE, "agent");
            asm volatile("s_waitcnt vmcnt(0)" ::: "memory");
        }
    }
    __syncthreads();
}

template <class Epi> __device__ __forceinline__ void run_gemm(LAS unsigned char* lds, const bf16_t* A, const bf16_t* Bt, int N, int K, const Epi E, int rot, int gsub = 0, int csub = 0) {
    asm volatile("" : "+s"(K), "+s"(N));
    pg8::Gemm g{A, Bt, MROWS, N, K}; pg8::StaticOrder S;
    if (gsub > 0) S.init(MROWS, N, gsub, csub);
    else S.init(MROWS, N, (int)gridDim.x, (int)((blockIdx.x + rot) % gridDim.x));
    pg8::gemm_phase<Epi, pg8::StaticOrder, false>((PG8_LAS unsigned char*)lds, g, S, E, nullptr);
}

template <class Epi> __device__ __forceinline__ void run_gemm_range(LAS unsigned char* lds, const bf16_t* A, const bf16_t* Bt, int N, int K, const Epi E, int i0, int i1) {
    asm volatile("" : "+s"(K), "+s"(N), "+s"(i0), "+s"(i1));
    pg8::Gemm g{A, Bt, MROWS, N, K}; pg8::RangeOrder S; S.init(MROWS, N, (int)gridDim.x, (int)blockIdx.x); S.i0 = i0; S.i1 = i1;
    pg8::gemm_phase<Epi, pg8::RangeOrder, false>((PG8_LAS unsigned char*)lds, g, S, E, nullptr);
}
#define COMMA ,
#define GEMM_THEN_LN(EPI_DECL, AOP, BOP, KK, LNG, LNB, XBO, OUTP, OUTS, STATSP) do { \
    if (gridDim.x == 256) { \
        _Pragma("unroll 1") for (int part = 0; part < 2; ++part) { \
            if (part == 0 || blockIdx.x < 8) { EPI_DECL; run_gemm_range(lds, AOP, BOP, DM, KK, E, part * 4, part ? 5 : 4); } \
            else ln_tiles(0, R, LNG, LNB, XBO, OUTP, OUTS, STATSP); \
            xcd_barrier(xbar); } \
        ln_tiles(1, R, LNG, LNB, XBO, OUTP, OUTS, STATSP); \
    } else { { EPI_DECL; run_gemm(lds, AOP, BOP, DM, KK, E, 0); } xcd_barrier(xbar); ln_phase(R, LNG, LNB, XBO, OUTP, OUTS, STATSP); } } while (0)
__global__ void __launch_bounds__(NTHREADS, 2) mega_fwd(Params p_unused) {
    extern __shared__ __attribute__((aligned(16))) unsigned char lds_raw[];
    LAS unsigned char* lds = (LAS unsigned char*)lds_raw;
    cg::grid_group grid = cg::this_grid();
    unsigned char* ws = fresh_params().ws;
    bf16_t* WT = (bf16_t*)(ws + OFF_WT); float* R = (float*)(ws + OFF_R); bf16_t* XB = (bf16_t*)(ws + OFF_XB); bf16_t* HZ = (bf16_t*)(ws + OFF_HZ);
    bf16_t* PB = (bf16_t*)(ws + OFF_PB); bf16_t* PPb = (bf16_t*)(ws + OFF_PP); bf16_t* POOLED = PPb; float* STATS = (float*)(ws + OFF_STATS); const float* GB = (const float*)(ws + OFF_GB);

    if (threadIdx.x < 4) ((LAS unsigned*)(lds + LDS_XB))[threadIdx.x] = 0u;
    __syncthreads();
    const XcdBarrier xbar = xcd_barrier_post((unsigned*)(ws + OFF_BAR), (volatile LAS unsigned*)(lds + LDS_XB));
    prologue(lds);
    grid.sync();
    for (int l = 0; l < 2; ++l) {
        const Params& p = fresh_params();
        const bf16_t* W = WT + (size_t)l * WT_LAYER;
        { pg8::EpiSwiglu E{HZ, DFF}; run_gemm(lds, XB, W + WT_FFN1IN, 2 * DFF, DM, E, 0); }
        xcd_barrier(xbar);
        if (l == 0) GEMM_THEN_LN(pg8::EpiResidIn E{p.in[0] COMMA p.in[1] - (size_t)MP * DM COMMA MP COMMA R COMMA ALPHA_F COMMA 0.5f}, HZ, W + WT_FFN1OUT, DFF, p.in[7] + l * DM, p.in[8] + l * DM, XB, nullptr, nullptr, STATS);
        else GEMM_THEN_LN(pg8::EpiResidLN<false COMMA true> E{R COMMA nullptr COMMA (int)(OFF_STATS - OFF_R) COMMA (int)(OFF_GB - OFF_R) + 2 * 8192}, HZ, W + WT_FFN1OUT, DFF, p.in[7] + l * DM, p.in[8] + l * DM, XB, nullptr, nullptr, STATS);
        xcd_barrier(xbar);
        { pg8::EpiStoreBf16 E{HZ, NIN, nullptr}; run_gemm(lds, XB, W + WT_WIN, NIN, DM, E, 0); }
        xcd_barrier(xbar);
        mixprep_phase(l, HZ, POOLED, POOLED + (size_t)MROWS * 256);
        xcd_barrier(xbar);
        if (gridDim.x == 256) { if (blockIdx.x >= 192) { pg8::EpiStoreBf16 E{XB, DM, p.in[20] + l * 256}; run_gemm(lds, POOLED, W + WT_POOL, 256, 256, E, 0, 64, (int)blockIdx.x - 192); } }
        else { pg8::EpiStoreBf16 E{XB, DM, p.in[20] + l * 256}; run_gemm(lds, POOLED, W + WT_POOL, 256, 256, E, 0); }
        scan_phase(l, HZ, POOLED + (size_t)MROWS * 256, XB, lds);
        xcd_barrier(xbar);
        GEMM_THEN_LN(pg8::EpiResidLN<false COMMA false> E{R COMMA nullptr COMMA (int)(OFF_STATS - OFF_R) COMMA (int)(OFF_GB - OFF_R) + (l * 3 + 0) * 8192}, XB, W + WT_WOUT, DM, p.in[9] + l * DM, p.in[10] + l * DM, XB, nullptr, nullptr, STATS);
        xcd_barrier(xbar);
        { pg8::EpiSwiglu E{HZ, DFF}; run_gemm(lds, XB, W + WT_FFN2IN, 2 * DFF, DM, E, 0); }
        xcd_barrier(xbar);
        { pg8::EpiResidLN<true, true> E{R, XB, (int)(OFF_STATS - OFF_R), (int)(OFF_GB - OFF_R) + (l * 3 + 1) * 8192}; run_gemm(lds, HZ, W + WT_FFN2OUT, DM, DFF, E, 0); }
        { pg8::EpiStoreBf16 E{PPb, DM, nullptr}; const bool sub = gridDim.x == 256;
          if (!sub || blockIdx.x >= 8) run_gemm(lds, PB + (size_t)l * MROWS * 256, W + WT_PLE, DM, 256, E, sub ? 0 : 128, sub ? 248 : 0, sub ? (int)blockIdx.x - 8 : 0); }
        xcd_barrier(xbar);
        GEMM_THEN_LN(pg8::EpiGate E{R COMMA PPb COMMA p.in[33] + l * DM COMMA DM}, XB, W + WT_GATE, DM, p.in[11] + l * DM, p.in[12] + l * DM, (l == 0 ? XB : (bf16_t*)nullptr), (l == 0 ? (float*)nullptr : p.out + O_YP), (l == 0 ? (float*)nullptr : p.out + O_YS), (l == 0 ? STATS : (float*)nullptr));
        if (l == 0) xcd_barrier(xbar);
    }
}

extern "C" void kernel_launch(void* const* d_in, const int* in_sizes, int n_in, void* d_out, int out_size, void* d_ws, size_t ws_size, hipStream_t stream) {
    static int grid_blocks = 0;
    if (grid_blocks == 0) {
        if (n_in != 35 || ws_size < WS_END) { fprintf(stderr, "kernel_launch: expected 35 inputs and >= %zu bytes of workspace, got %d and %zu\n", (size_t)WS_END, n_in, ws_size); grid_blocks = -1; return; }
        int dev = 0, cus = 0, per_cu = 0;
        hipGetDevice(&dev);
        hipDeviceGetAttribute(&cus, hipDeviceAttributeMultiprocessorCount, dev);
        if (hipFuncSetAttribute((const void*)mega_fwd, hipFuncAttributeMaxDynamicSharedMemorySize, LDS_BYTES) != hipSuccess) { fprintf(stderr, "kernel_launch: hipFuncSetAttribute failed\n"); (void)hipGetLastError(); }
        if (hipOccupancyMaxActiveBlocksPerMultiprocessor(&per_cu, (const void*)mega_fwd, NTHREADS, LDS_BYTES) != hipSuccess || per_cu < 1) { fprintf(stderr, "kernel_launch: occupancy query gave %d\n", per_cu); per_cu = 1; (void)hipGetLastError(); }
        grid_blocks = cus * per_cu;
    }
    if (grid_blocks < 0) return;
    Params p{};
    for (int i = 0; i < 35; ++i) p.in[i] = (const float*)d_in[i];
    p.out = (float*)d_out; p.ws = (unsigned char*)d_ws;
    (void)hipMemsetAsync((char*)d_ws + OFF_BAR, 0, 13824, stream);
    void* args[] = {&p};
    hipError_t e = hipLaunchCooperativeKernel((const void*)mega_fwd, dim3(grid_blocks), dim3(NTHREADS), args, LDS_BYTES, stream);
    if (e != hipSuccess) fprintf(stderr, "cooperative launch failed: %s (grid %d)\n", hipGetErrorString(e), grid_blocks);
}
```

```cpp
#include <hip/hip_runtime.h>
#include <hip/hip_cooperative_groups.h>
#include <cstdio>
namespace cg = cooperative_groups;
namespace pg8 {
#define PG8_LAS __attribute__((address_space(3)))
typedef unsigned short bf16_t;
typedef short bf16x8 __attribute__((ext_vector_type(8)));
typedef float f32x4 __attribute__((ext_vector_type(4)));
typedef unsigned u32x4 __attribute__((ext_vector_type(4)));
constexpr int BM = 256, BK = 64, HALF = 128, HTB = HALF * BK * 2  , STAGE_BYTES = 8 * HTB, NXCD = 8, WGM = 6;

__host__ __device__ __forceinline__ int lds_byte(int r, int c) { const int st = (r >> 4) * 2 + (c >> 5), rr = r & 15, cc = c & 31, ob = rr * 64 + cc * 2; return st * 1024 + (ob ^ (((ob >> 9) & 1) << 5)); }
__host__ __device__ __forceinline__ void stage_rc(int b, int& R, int& C) { const int st = b / 1024, sb = b % 1024, swz = sb ^ (((sb >> 9) & 1) << 5); R = (st >> 1) * 16 + swz / 64; C = (st & 1) * 32 + (swz % 64) / 2; }
__host__ __device__ __forceinline__ int perm32(int rho) { const int n = rho >> 4, i = rho & 15; return 8 * (i >> 2) + 4 * n + (i & 3); }

struct Unit { int pm, pn; };
struct Gemm { const bf16_t* A; const bf16_t* Bt; int M, N, K; };

struct StaticOrder {
    int nM, nN, nwg, G, c;
    __host__ __device__ void init(int M, int N, int G_, int c_) { nM = M / BM; nN = N / BM; nwg = nM * nN; G = G_; c = c_; }
    __host__ __device__ bool next(int i, Unit& u) const {
        const long L = (long)i * G + c; if (L >= nwg) return false;
        int wgid = (int)L; { const int q = nwg / NXCD, r = nwg % NXCD, xcd = wgid % NXCD, off = wgid / NXCD; wgid = (xcd < r ? xcd * (q + 1) : r * (q + 1) + (xcd - r) * q) + off; }
        const int nig = WGM * nN, gid = wgid / nig, fm = gid * WGM, gsz = (nM - fm) < WGM ? (nM - fm) : WGM;
        u.pm = fm + ((wgid % nig) % gsz); u.pn = (wgid % nig) / gsz; return true;
    }
    __device__ __forceinline__ void a_ready(const Unit&) const {}
    __device__ __forceinline__ void done(const Unit&) const {}
};
struct RangeOrder : StaticOrder { int i0, i1;
    __host__ __device__ bool next(int i, Unit& u) const { return (i + i0 < i1) && StaticOrder::next(i + i0, u); } };
__device__ __forceinline__ unsigned cvt_pk_bf16(float lo, float hi) { typedef float f2_ __attribute__((ext_vector_type(2))); typedef __bf16 b2_ __attribute__((ext_vector_type(2))); const f2_ v = {lo, hi}; return __builtin_bit_cast(unsigned, __builtin_convertvector(v, b2_)); }
typedef float f32x2 __attribute__((ext_vector_type(2)));
typedef unsigned u32x2 __attribute__((ext_vector_type(2)));
__device__ __forceinline__ float fast_sigmoid(float x) { return __builtin_amdgcn_rcpf(1.0f + __builtin_amdgcn_exp2f(-1.4426950408889634f * x)); }

struct EpiSwiglu {
    static constexpr bool PERM = true, AFTER_DRAIN = false;
    bf16_t* H; int ldh;
    __device__ __forceinline__ void operator()(const f32x4 (&acc)[2][2][4][2], const Unit& u, int wr, int wc, int fr, int fq) const {
        const int row0 = u.pm * BM + wr * 64 + fr, col0 = u.pn * HALF + wc * 32 + 8 * fq;
#pragma unroll
        for (int ai = 0; ai < 2; ++ai)
#pragma unroll
            for (int m = 0; m < 4; ++m) {
                bf16_t* rowp = H + (size_t)(row0 + ai * HALF + m * 16) * ldh + col0;
                float h[8];
#pragma unroll
                for (int n = 0; n < 2; ++n)
#pragma unroll
                    for (int j = 0; j < 4; ++j) { const float g = acc[ai][0][m][n][j], up = acc[ai][1][m][n][j]; h[n * 4 + j] = g * fast_sigmoid(g) * up; }
                u32x4 w; w.x = cvt_pk_bf16(h[0], h[1]); w.y = cvt_pk_bf16(h[2], h[3]); w.z = cvt_pk_bf16(h[4], h[5]); w.w = cvt_pk_bf16(h[6], h[7]);
                *(u32x4*)rowp = w;
            }
    }
};
struct EpiStoreBf16 {
    static constexpr bool PERM = true, AFTER_DRAIN = false;
    bf16_t* O; int ldc; const float* cscale;
    __device__ __forceinline__ void operator()(const f32x4 (&acc)[2][2][4][2], const Unit& u, int wr, int wc, int fr, int fq) const {
        const int row0 = u.pm * BM + wr * 64 + fr, col0 = u.pn * BM + wc * 32 + 8 * fq;
        f32x4 sc[2][2];
#pragma unroll
        for (int bj = 0; bj < 2; ++bj)
#pragma unroll
            for (int n = 0; n < 2; ++n) sc[bj][n] = cscale ? *(const f32x4*)(cscale + col0 + bj * HALF + 4 * n) : (f32x4){1.f, 1.f, 1.f, 1.f};
#pragma unroll
        for (int ai = 0; ai < 2; ++ai)
#pragma unroll
            for (int m = 0; m < 4; ++m) { bf16_t* rowp = O + (size_t)(row0 + ai * HALF + m * 16) * ldc + col0;
#pragma unroll
                for (int bj = 0; bj < 2; ++bj) { const f32x4 v0 = acc[ai][bj][m][0] * sc[bj][0], v1 = acc[ai][bj][m][1] * sc[bj][1];
                    u32x4 w; w.x = cvt_pk_bf16(v0[0], v0[1]); w.y = cvt_pk_bf16(v0[2], v0[3]); w.z = cvt_pk_bf16(v1[0], v1[1]); w.w = cvt_pk_bf16(v1[2], v1[3]);
                    *(u32x4*)(rowp + bj * HALF) = w; } }
    }
};
struct EpiResidIn {
    static constexpr bool PERM = false, AFTER_DRAIN = false;
    const float* srcA; const float* srcB; int split_row; float* out; float sa, sb;
    __device__ __forceinline__ void operator()(const f32x4 (&acc)[2][2][4][2], const Unit& u, int wr, int wc, int fr, int fq) const {
        constexpr int ldc = 1024;
        const int row0 = u.pm * BM + wr * 64 + fr, col0 = u.pn * BM + wc * 32 + 4 * fq;
        const float* src = (u.pm * BM >= split_row) ? srcB : srcA;
#pragma unroll
        for (int ai = 0; ai < 2; ++ai)
#pragma unroll
            for (int m = 0; m < 4; ++m) { const size_t off = (size_t)(row0 + ai * HALF + m * 16) * ldc + col0;
#pragma unroll
                for (int bj = 0; bj < 2; ++bj)
#pragma unroll
                    for (int n = 0; n < 2; ++n) { const f32x4 s = *(const f32x4*)(src + off + bj * HALF + n * 16); *(f32x4*)(out + off + bj * HALF + n * 16) = s * sa + acc[ai][bj][m][n] * sb; }
                asm volatile("" ::: "memory"); }
    }
};
template <bool OB, bool SBHALF> struct EpiResidLN {
    static constexpr bool PERM = false, AFTER_DRAIN = false;
    float* out; bf16_t* ob; int stats_off, gb_off;
    __device__ __forceinline__ void operator()(const f32x4 (&acc)[2][2][4][2], const Unit& u, int wr, int wc, int fr, int fq) const {
        constexpr int ldc = 1024;
        const int row0 = u.pm * BM + wr * 64 + fr, col0 = u.pn * BM + wc * 32 + 4 * fq;
        float* const out = this->out; bf16_t* const ob = this->ob; const float sa = 1.4142135623730951f, sb = SBHALF ? 0.5f : 1.0f;
        const float* const stats = (const float*)((const char*)out + stats_off); const float* const gb = (const float*)((const char*)out + gb_off);
#pragma unroll
        for (int bj = 0; bj < 2; ++bj)
#pragma unroll
            for (int n = 0; n < 2; ++n) {
                const int cc = col0 + bj * HALF + n * 16;
                const f32x4 gv = *(const f32x4*)(gb + cc), bv = *(const f32x4*)(gb + 1024 + cc);
#pragma unroll
                for (int ai = 0; ai < 2; ++ai)
#pragma unroll
                    for (int m = 0; m < 4; ++m) { const int row = row0 + ai * HALF + m * 16; const unsigned off = (unsigned)row * ldc + cc;
                        const f32x4 s0 = *(const f32x4*)(out + off); const f32x2 st = *(const f32x2*)(stats + 2u * (unsigned)row);
                        const f32x4 o = ((s0 - st.x) * st.y * gv + bv) * sa + acc[ai][bj][m][n] * sb;
                        *(f32x4*)(out + off) = o;
                        if (OB) { u32x2 w; w.x = cvt_pk_bf16(o[0], o[1]); w.y = cvt_pk_bf16(o[2], o[3]); *(u32x2*)(ob + off) = w; } }
                asm volatile("" ::: "memory"); }
    }
};
struct EpiGate {
    static constexpr bool PERM = false, AFTER_DRAIN = false;
    float* R; const bf16_t* PP; const float* bias; int ldc;
    __device__ __forceinline__ void operator()(const f32x4 (&acc)[2][2][4][2], const Unit& u, int wr, int wc, int fr, int fq) const {
        const int row0 = u.pm * BM + wr * 64 + fr, col0 = u.pn * BM + wc * 32 + 4 * fq;
        f32x4 bv[2][2];
#pragma unroll
        for (int bj = 0; bj < 2; ++bj)
#pragma unroll
            for (int n = 0; n < 2; ++n) bv[bj][n] = *(const f32x4*)(bias + col0 + bj * HALF + n * 16);
#pragma unroll
        for (int ai = 0; ai < 2; ++ai)
#pragma unroll
            for (int m = 0; m < 4; ++m) { const size_t off = (size_t)(row0 + ai * HALF + m * 16) * ldc + col0;
#pragma unroll
                for (int bj = 0; bj < 2; ++bj)
#pragma unroll
                    for (int n = 0; n < 2; ++n) { const size_t o2 = off + bj * HALF + n * 16; const f32x4 s = *(const f32x4*)(R + o2); const u32x2 pw = *(const u32x2*)(PP + o2);
                        const f32x4 a = acc[ai][bj][m][n] + bv[bj][n]; f32x4 o;
                        o[0] = s[0] + fast_sigmoid(a[0]) * __uint_as_float(pw.x << 16); o[1] = s[1] + fast_sigmoid(a[1]) * __uint_as_float(pw.x & 0xffff0000u);
                        o[2] = s[2] + fast_sigmoid(a[2]) * __uint_as_float(pw.y << 16); o[3] = s[3] + fast_sigmoid(a[3]) * __uint_as_float(pw.y & 0xffff0000u);
                        *(f32x4*)(R + o2) = o; }
                asm volatile("" ::: "memory"); }
    }
};
template <class Epi, class Sched, bool STAMP = false>
__device__ __forceinline__ void gemm_phase(PG8_LAS unsigned char* lds, const Gemm g, const Sched& S, const Epi& E, unsigned long long* stamps) {
    int tid_l = threadIdx.x; asm volatile("" : "+v"(tid_l));
    const int tid = tid_l, wid = __builtin_amdgcn_readfirstlane(tid >> 6), lane = tid & 63, wr = wid >> 2, wc = wid & 3, fr = lane & 15, fq = lane >> 4;
    const int K = g.K, nt = K / BK;
    int ts_lo = 0, ts_hi = 0, nts = 0; const unsigned long long rt_entry = STAMP ? (unsigned long long)wall_clock64() : 0ull;
#define PG8_STAMP() do { if (STAMP && wid == 0 && nts < 64) { const unsigned long long _c = (unsigned long long)clock64(); \
        ts_lo = (lane == nts) ? (int)(unsigned)_c : ts_lo; ts_hi = (lane == nts) ? (int)(unsigned)(_c >> 32) : ts_hi; ++nts; } } while (0)
    PG8_STAMP();
    unsigned voffA[2], voffB[2];
#pragma unroll
    for (int i = 0; i < 2; ++i) { int R, C; stage_rc(tid * 16 + i * 8192, R, C); const int Rb = Epi::PERM ? ((R & ~31) + perm32(R & 31)) : R;
        voffA[i] = (unsigned)(R * K + C) * 2u; voffB[i] = (unsigned)(Rb * K + C) * 2u; }
    const size_t kstep = (size_t)(BK * 2);
    const size_t hstep = (size_t)HALF * K * 2;
    const size_t tstep = 2 * hstep;
    const unsigned ldsw = (unsigned)wid * 1024u;
    const int aoff = lds_byte(wr * 64 + fr, fq * 8), boff = lds_byte(wc * 32 + fr, fq * 8);
#define PG8_SA(b, h) (((b) * 2 + (h)) * HTB)
#define PG8_SB(b, h) ((4 + (b) * 2 + (h)) * HTB)
#define PG8_STAGE(bufoff, gbase, voff) do { _Pragma("unroll") for (int _i = 0; _i < 2; ++_i) \
        __builtin_amdgcn_global_load_lds((const unsigned*)((const char*)(gbase) + (voff)[_i]), (PG8_LAS unsigned*)(lds + (bufoff) + ldsw + _i * 8192), 16, 0, 0); } while (0)
#define PG8_LDA(dst, b, h) do { _Pragma("unroll") for (int m = 0; m < 4; ++m) _Pragma("unroll") for (int k = 0; k < 2; ++k) dst[m][k] = *(const PG8_LAS bf16x8*)(lds + PG8_SA(b, h) + aoff + m * 2048 + k * 1024); } while (0)
#define PG8_LDB(dst, b, h) do { _Pragma("unroll") for (int n = 0; n < 2; ++n) _Pragma("unroll") for (int k = 0; k < 2; ++k) dst[n][k] = *(const PG8_LAS bf16x8*)(lds + PG8_SB(b, h) + boff + n * 2048 + k * 1024); } while (0)
#define PG8_MMA(ai, bj, At, Bt) do { __builtin_amdgcn_s_setprio(1); _Pragma("unroll") for (int m = 0; m < 4; ++m) _Pragma("unroll") for (int n = 0; n < 2; ++n) _Pragma("unroll") for (int k = 0; k < 2; ++k) \
        acc[ai][bj][m][n] = __builtin_amdgcn_mfma_f32_16x16x32_bf16(Bt[n][k], At[m][k], acc[ai][bj][m][n], 0, 0, 0); __builtin_amdgcn_s_setprio(0); } while (0)
#define PG8_WAIT_V(n) asm volatile("s_waitcnt vmcnt(" #n ")" ::: "memory")
#define PG8_WAIT_L(n) asm volatile("s_waitcnt lgkmcnt(" #n ")" ::: "memory")
#define PG8_BAR __builtin_amdgcn_s_barrier()
#define PG8_SCHED __builtin_amdgcn_sched_barrier(0)
    Unit cur, nxt; int ui = 0;
    if (!S.next(0, cur)) return;
    f32x4 acc[2][2][4][2];
#pragma unroll
    for (int a = 0; a < 2; ++a)
#pragma unroll
        for (int b = 0; b < 2; ++b)
#pragma unroll
            for (int m = 0; m < 4; ++m)
#pragma unroll
                for (int n = 0; n < 2; ++n) acc[a][b][m][n] = (f32x4){0.f, 0.f, 0.f, 0.f};
    bf16x8 At[4][2], B0[2][2], B1[2][2];
    const char* cA = (const char*)g.A + (size_t)cur.pm * tstep; const char* cB = (const char*)g.Bt + (size_t)cur.pn * tstep;
    S.a_ready(cur);
    PG8_STAGE(PG8_SB(0, 0), cB, voffB); PG8_STAGE(PG8_SA(0, 0), cA, voffA); PG8_STAGE(PG8_SB(0, 1), cB + hstep, voffB); PG8_STAGE(PG8_SA(0, 1), cA + hstep, voffA);
    if (wr == 1) PG8_BAR;
    PG8_WAIT_V(4); PG8_BAR;
    PG8_STAGE(PG8_SB(1, 0), cB + kstep, voffB); PG8_STAGE(PG8_SA(1, 0), cA + kstep, voffA); PG8_STAGE(PG8_SB(1, 1), cB + hstep + kstep, voffB);
    PG8_WAIT_V(6); PG8_BAR;
    PG8_STAMP();
    for (;;) {
        const bool has_next = S.next(ui + 1, nxt);
        const char* nA = has_next ? (const char*)g.A + (size_t)nxt.pm * tstep : cA; const char* nB = has_next ? (const char*)g.Bt + (size_t)nxt.pn * tstep : cB;
        for (int t = 0; t < nt; t += 2) {
            const bool last = (t == nt - 2);
            const char* a1 = cA + (size_t)(t + 1) * kstep;
            const char* a2 = last ? nA : cA + (size_t)(t + 2) * kstep; const char* b2 = last ? nB : cB + (size_t)(t + 2) * kstep;
            const char* a3 = a2 + kstep; const char* b3 = b2 + kstep;
            if (last && has_next) S.a_ready(nxt);
            PG8_LDB(B0, 0, 0); PG8_SCHED; PG8_LDA(At, 0, 0); PG8_STAGE(PG8_SA(1, 1), a1 + hstep, voffA);
            PG8_WAIT_L(8); PG8_BAR; PG8_WAIT_L(0); PG8_MMA(0, 0, At, B0); PG8_BAR; PG8_SCHED;
            PG8_LDB(B1, 0, 1); PG8_STAGE(PG8_SB(0, 0), b2, voffB);
            PG8_BAR; PG8_WAIT_L(0); PG8_MMA(0, 1, At, B1); PG8_BAR;
            PG8_LDA(At, 0, 1); PG8_STAGE(PG8_SA(0, 0), a2, voffA);
            PG8_BAR; PG8_WAIT_L(0); PG8_MMA(1, 0, At, B0); PG8_BAR; PG8_SCHED;
            PG8_STAGE(PG8_SB(0, 1), b2 + hstep, voffB);
            PG8_WAIT_V(6); PG8_BAR; PG8_MMA(1, 1, At, B1); PG8_BAR;
            PG8_LDB(B0, 1, 0); PG8_SCHED; PG8_LDA(At, 1, 0); PG8_STAGE(PG8_SA(0, 1), a2 + hstep, voffA);
            PG8_WAIT_L(8); PG8_BAR; PG8_WAIT_L(0); PG8_MMA(0, 0, At, B0); PG8_BAR; PG8_SCHED;
            PG8_LDB(B1, 1, 1); PG8_STAGE(PG8_SB(1, 0), b3, voffB);
            PG8_BAR; PG8_WAIT_L(0); PG8_MMA(0, 1, At, B1); PG8_BAR;
            PG8_LDA(At, 1, 1); PG8_STAGE(PG8_SA(1, 0), a3, voffA);
            PG8_BAR; PG8_WAIT_L(0); PG8_MMA(1, 0, At, B0); PG8_BAR; PG8_SCHED;
            PG8_STAGE(PG8_SB(1, 1), b3 + hstep, voffB);
            PG8_WAIT_V(6); PG8_BAR; PG8_MMA(1, 1, At, B1); PG8_BAR;
        }
        PG8_STAMP();
        if constexpr (!Epi::AFTER_DRAIN) { E(acc, cur, wr, wc, fr, fq); S.done(cur); }
        PG8_STAMP();
        if (!has_next) break;
#pragma unroll
        for (int a = 0; a < 2; ++a)
#pragma unroll
            for (int b = 0; b < 2; ++b)
#pragma unroll
                for (int m = 0; m < 4; ++m)
#pragma unroll
                    for (int n = 0; n < 2; ++n) acc[a][b][m][n] = (f32x4){0.f, 0.f, 0.f, 0.f};
        cur = nxt; cA = nA; cB = nB; ++ui;
    }
    PG8_WAIT_V(0);
    if (wr == 0) PG8_BAR;
    PG8_BAR;
    if constexpr (Epi::AFTER_DRAIN) { E.fused(acc, cur, wr, wc, fr, fq, lds, wid, lane); S.done(cur); }
    PG8_STAMP();
    if (STAMP && wid == 0) { stamps[lane] = lane < nts ? (((unsigned long long)(unsigned)ts_hi << 32) | (unsigned)ts_lo) : 0ull;
        if (lane == 62) stamps[62] = rt_entry; if (lane == 63) stamps[63] = (unsigned long long)wall_clock64(); }
#undef PG8_STAMP
#undef PG8_SA
#undef PG8_SB
#undef PG8_STAGE
#undef PG8_LDA
#undef PG8_LDB
#undef PG8_MMA
#undef PG8_WAIT_V
#undef PG8_WAIT_L
#undef PG8_BAR
#undef PG8_SCHED
}
}

#define LAS __attribute__((address_space(3)))
typedef unsigned short bf16_t;
typedef short bf16x8 __attribute__((ext_vector_type(8)));
typedef float f32x4 __attribute__((ext_vector_type(4)));
typedef unsigned u32x4 __attribute__((ext_vector_type(4)));
typedef unsigned u32x2 __attribute__((ext_vector_type(2)));
typedef float f32x2s __attribute__((ext_vector_type(2)));

constexpr int MROWS = 66048, MP = 65536, DM = 1024, DFF = 2816, NIN = 2816, NHEAD = 12;
constexpr float ALPHA_F = 1.4142135623730951f;
constexpr int LDS_XB = 156992;
constexpr int LDS_BYTES = 157056;
constexpr int NTHREADS = 512;
constexpr size_t WT_FFN1IN = 0, WT_FFN1OUT = 5767168, WT_WIN = 8650752, WT_POOL = 11534336, WT_WOUT = 11599872, WT_FFN2IN = 12648448, WT_FFN2OUT = 18415616,
                 WT_GATE = 21299200, WT_PLE = 22347776, WT_LAYER = 22609920;
constexpr size_t OFF_WT = 0, OFF_R = 90439680, OFF_XB = 360972288, OFF_HZ = 496238592, OFF_PB = 868220928, OFF_PP = 935854080, OFF_STATS = 1071120384, OFF_GB = 1071648768, OFF_BAR = 1071697920, WS_END = 1071711744;
constexpr size_t O_YP = 0, O_YS = 67108864, O_PP = 67633152, O_SP = 67756032, O_WP = 67837952, O_PS = 69410816, O_SS = 69533696, O_WS = 69615616;

struct Params { const float* in[35]; float* out; unsigned char* ws; };

__device__ __forceinline__ float bf_lo(unsigned w) { return __uint_as_float(w << 16); }
__device__ __forceinline__ float bf_hi(unsigned w) { return __uint_as_float(w & 0xffff0000u); }
__device__ __forceinline__ unsigned short f2bf(float f) { return (unsigned short)(pg8::cvt_pk_bf16(f, 0.f) & 0xffffu); }
__device__ __forceinline__ float wave_sum(float v) {
#pragma unroll
    for (int o = 32; o >= 1; o >>= 1) v += __shfl_xor(v, o);
    return v;
}
__device__ __forceinline__ const Params& fresh_params() { auto k = __builtin_amdgcn_kernarg_segment_ptr(); asm volatile("" : "+s"(k)); return *(const Params*)k; }
__device__ __forceinline__ int fresh_tid() { int t = threadIdx.x; asm volatile("" : "+v"(t)); return t; }
template <int CTRL> __device__ __forceinline__ float dpp_mov(float v) { return __builtin_bit_cast(float, __builtin_amdgcn_update_dpp(0, __builtin_bit_cast(int, v), CTRL, 0xF, 0xF, true)); }
__device__ __forceinline__ float allreduce8(float v) { v += dpp_mov<0xB1>(v); v += dpp_mov<0x4E>(v); v += dpp_mov<0x141>(v); return v; }
__device__ __forceinline__ float fsig(float x) { return __builtin_amdgcn_rcpf(1.0f + __builtin_amdgcn_exp2f(-1.4426950408889634f * x)); }
__device__ __forceinline__ float ftanh(float x) { return 1.0f - 2.0f * __builtin_amdgcn_rcpf(1.0f + __builtin_amdgcn_exp2f(2.8853900817779268f * x)); }

__device__ void convert_weight(const float* src, int K, int Nsrc, int Nd, int mode, bf16_t* dst, LAS float* tile) {
    const int tid = fresh_tid(), ntn = Nd / 64, ntk = K / 64;
    for (int t = blockIdx.x; t < ntn * ntk; t += gridDim.x) {
        const int tn = t % ntn, tk = t / ntn, n0 = tn * 64, k0 = tk * 64;
        int c0 = n0;
        if (mode == 1) { const int pn = n0 >> 8, w = n0 & 255; c0 = (w < 128) ? (128 * pn + w) : (DFF + 128 * pn + (w - 128)); }
#pragma unroll
        for (int i = 0; i < 2; ++i) { const int kk = (tid >> 4) + 32 * i, c4 = tid & 15;
            const f32x4 v = *(const f32x4*)(src + (size_t)(k0 + kk) * Nsrc + c0 + 4 * c4);
            tile[kk * 65 + 4 * c4 + 0] = v[0]; tile[kk * 65 + 4 * c4 + 1] = v[1]; tile[kk * 65 + 4 * c4 + 2] = v[2]; tile[kk * 65 + 4 * c4 + 3] = v[3]; }
        __syncthreads();
        { const int n = tid >> 3, k8 = tid & 7; float f[8];
#pragma unroll
            for (int j = 0; j < 8; ++j) f[j] = tile[(k8 * 8 + j) * 65 + n];
            u32x4 w; w.x = pg8::cvt_pk_bf16(f[0], f[1]); w.y = pg8::cvt_pk_bf16(f[2], f[3]); w.z = pg8::cvt_pk_bf16(f[4], f[5]); w.w = pg8::cvt_pk_bf16(f[6], f[7]);
            *(u32x4*)(dst + (size_t)(n0 + n) * K + k0 + k8 * 8) = w; }
        __syncthreads();
    }
}
__device__ void prologue(LAS unsigned char* lds) {
    const Params& p = fresh_params();
    LAS float* tile = (LAS float*)lds;
    bf16_t* WT = (bf16_t*)(p.ws + OFF_WT);
    for (int l = 0; l < 2; ++l) {
        bf16_t* W = WT + (size_t)l * WT_LAYER;
        convert_weight(p.in[13] + (size_t)l * DM * 2 * DFF, DM, 2 * DFF, 2 * DFF, 1, W + WT_FFN1IN, tile);
        convert_weight(p.in[14] + (size_t)l * DFF * DM, DFF, DM, DM, 0, W + WT_FFN1OUT, tile);
        convert_weight(p.in[17] + (size_t)l * DM * NIN, DM, NIN, NIN, 0, W + WT_WIN, tile);
        convert_weight(p.in[31] + (size_t)l * DM * DM, DM, DM, DM, 0, W + WT_WOUT, tile);
        convert_weight(p.in[15] + (size_t)l * DM * 2 * DFF, DM, 2 * DFF, 2 * DFF, 1, W + WT_FFN2IN, tile);
        convert_weight(p.in[16] + (size_t)l * DFF * DM, DFF, DM, DM, 0, W + WT_FFN2OUT, tile);
        convert_weight(p.in[32] + (size_t)l * DM * DM, DM, DM, DM, 0, W + WT_GATE, tile);
        convert_weight(p.in[34] + (size_t)l * 256 * DM, 256, DM, DM, 0, W + WT_PLE, tile);
        const float* pw = p.in[19] + (size_t)l * 4 * 64 * 64;
        for (int i = blockIdx.x * NTHREADS + fresh_tid(); i < 256 * 256; i += gridDim.x * NTHREADS) {
            const int n = i >> 8, k = i & 255, g = n >> 6, d = n & 63, g2 = k >> 6, c = k & 63;
            W[WT_POOL + i] = (g == g2) ? f2bf(pw[(g * 64 + c) * 64 + d]) : (bf16_t)0;
        }
    }
    { float* GBw = (float*)(p.ws + OFF_GB);
      for (int i = blockIdx.x * NTHREADS + fresh_tid(); i < 2 * 3 * 2048; i += gridDim.x * NTHREADS) {
          const int l = i / 6144, j = (i % 6144) / 2048, e = i % 2048;
          GBw[i] = p.in[7 + 2 * j + (e >> 10)][l * DM + (e & 1023)]; } }
    bf16_t* XB = (bf16_t*)(p.ws + OFF_XB);
    const size_t gt = (size_t)blockIdx.x * NTHREADS + fresh_tid(), gs = (size_t)gridDim.x * NTHREADS;
    for (size_t i = gt; i < (size_t)MROWS * DM / 8; i += gs) {
        const size_t e = i * 8; const float* s = (e < (size_t)MP * DM) ? p.in[0] + e : p.in[1] + (e - (size_t)MP * DM);
        const f32x4 a = *(const f32x4*)s, b = *(const f32x4*)(s + 4);
        u32x4 w; w.x = pg8::cvt_pk_bf16(a[0], a[1]); w.y = pg8::cvt_pk_bf16(a[2], a[3]); w.z = pg8::cvt_pk_bf16(b[0], b[1]); w.w = pg8::cvt_pk_bf16(b[2], b[3]);
        *(u32x4*)(XB + e) = w;
    }
    bf16_t* PB = (bf16_t*)(p.ws + OFF_PB);
    for (size_t i = gt; i < (size_t)2 * MROWS * 256 / 8; i += gs) {
        const size_t e = i * 8; const int l = (int)(e / ((size_t)MROWS * 256)); const size_t r = e - (size_t)l * MROWS * 256;
        const float* s = (r < (size_t)MP * 256) ? p.in[2] + (size_t)l * MP * 256 + r : p.in[3] + (size_t)l * 512 * 256 + (r - (size_t)MP * 256);
        const f32x4 a = *(const f32x4*)s, b = *(const f32x4*)(s + 4);
        u32x4 w; w.x = pg8::cvt_pk_bf16(a[0], a[1]); w.y = pg8::cvt_pk_bf16(a[2], a[3]); w.z = pg8::cvt_pk_bf16(b[0], b[1]); w.w = pg8::cvt_pk_bf16(b[2], b[3]);
        *(u32x4*)(PB + e) = w;
    }
}

__device__ __forceinline__ void ln_row(int row, int lane, float* R, const f32x4 (&gv)[4], const f32x4 (&bv)[4], bf16_t* xb, float* outp, float* outs, float* stats) {
    float* rp = R + (size_t)row * DM;
    f32x4 v[4]; float s = 0.f;
#pragma unroll
    for (int i = 0; i < 4; ++i) { v[i] = *(const f32x4*)(rp + i * 256 + lane * 4); s += (v[i][0] + v[i][1]) + (v[i][2] + v[i][3]); }
    const float mean = wave_sum(s) * (1.0f / 1024.0f);
    float q = 0.f;
#pragma unroll
    for (int i = 0; i < 4; ++i) { v[i] = v[i] - mean; q += (v[i][0] * v[i][0] + v[i][1] * v[i][1]) + (v[i][2] * v[i][2] + v[i][3] * v[i][3]); }
    const float rstd = 1.0f / sqrtf(wave_sum(q) * (1.0f / 1024.0f) + 1e-5f);
    float* op = outp ? ((row < MP) ? outp + (size_t)row * DM : outs + (size_t)(row - MP) * DM) : rp;
    if (stats && lane == 0) *(f32x2s*)(stats + 2 * (size_t)row) = (f32x2s){mean, rstd};
#pragma unroll
    for (int i = 0; i < 4; ++i) { const f32x4 y = v[i] * rstd * gv[i] + bv[i];
        if (!stats) *(f32x4*)(op + i * 256 + lane * 4) = y;
        if (xb) { u32x2 w; w.x = pg8::cvt_pk_bf16(y[0], y[1]); w.y = pg8::cvt_pk_bf16(y[2], y[3]); *(u32x2*)(xb + (size_t)row * DM + i * 256 + lane * 4) = w; } }
}
__device__ void ln_tiles(int part, float* R, const float* g, const float* b, bf16_t* xb, float* outp, float* outs, float* stats) {
    const int tid = fresh_tid(), lane = tid & 63, wave = tid >> 6;
    int s0, s1, s2, s3, s4, s5, s6, s7;
    { pg8::StaticOrder S8; pg8::Unit u8;
      S8.init(MROWS, DM, 256, 0); S8.next(4, u8); s0 = u8.pm; S8.init(MROWS, DM, 256, 1); S8.next(4, u8); s1 = u8.pm; S8.init(MROWS, DM, 256, 2); S8.next(4, u8); s2 = u8.pm; S8.init(MROWS, DM, 256, 3); S8.next(4, u8); s3 = u8.pm;
      S8.init(MROWS, DM, 256, 4); S8.next(4, u8); s4 = u8.pm; S8.init(MROWS, DM, 256, 5); S8.next(4, u8); s5 = u8.pm; S8.init(MROWS, DM, 256, 6); S8.next(4, u8); s6 = u8.pm; S8.init(MROWS, DM, 256, 7); S8.next(4, u8); s7 = u8.pm; }
    f32x4 gv[4], bv[4];
#pragma unroll
    for (int i = 0; i < 4; ++i) { gv[i] = *(const f32x4*)(g + i * 256 + lane * 4); bv[i] = *(const f32x4*)(b + i * 256 + lane * 4); }
    if (part == 0) {
        const int wg = (int)blockIdx.x - 8, nwg = (int)gridDim.x - 8;
        for (int row = wg * 8 + wave; row < MROWS; row += nwg * 8) {
            const int t = row >> 8;
            if (t == s0 || t == s1 || t == s2 || t == s3 || t == s4 || t == s5 || t == s6 || t == s7) continue;
            ln_row(row, lane, R, gv, bv, xb, outp, outs, stats);
        }
    } else {
        for (int idx = blockIdx.x * 8 + wave; idx < 8 * 256; idx += gridDim.x * 8) {
            const int j = idx >> 8, t = j == 0 ? s0 : j == 1 ? s1 : j == 2 ? s2 : j == 3 ? s3 : j == 4 ? s4 : j == 5 ? s5 : j == 6 ? s6 : s7;
            ln_row(t * 256 + (idx & 255), lane, R, gv, bv, xb, outp, outs, stats);
        }
    }
}
__device__ void ln_phase(float* R, const float* g, const float* b, bf16_t* xb, float* outp, float* outs, float* stats) {
    const int tid = fresh_tid(), lane = tid & 63, wave = tid >> 6;
    f32x4 gv[4], bv[4];
#pragma unroll
    for (int i = 0; i < 4; ++i) { gv[i] = *(const f32x4*)(g + i * 256 + lane * 4); bv[i] = *(const f32x4*)(b + i * 256 + lane * 4); }
    for (int row = blockIdx.x * 8 + wave; row < MROWS; row += gridDim.x * 8) {
        float* rp = R + (size_t)row * DM;
        f32x4 v[4]; float s = 0.f;
#pragma unroll
        for (int i = 0; i < 4; ++i) { v[i] = *(const f32x4*)(rp + i * 256 + lane * 4); s += (v[i][0] + v[i][1]) + (v[i][2] + v[i][3]); }
        const float mean = wave_sum(s) * (1.0f / 1024.0f);
        float q = 0.f;
#pragma unroll
        for (int i = 0; i < 4; ++i) { v[i] = v[i] - mean; q += (v[i][0] * v[i][0] + v[i][1] * v[i][1]) + (v[i][2] * v[i][2] + v[i][3] * v[i][3]); }
        const float rstd = 1.0f / sqrtf(wave_sum(q) * (1.0f / 1024.0f) + 1e-5f);
        float* op = outp ? ((row < MP) ? outp + (size_t)row * DM : outs + (size_t)(row - MP) * DM) : rp;
        if (stats && lane == 0) *(f32x2s*)(stats + 2 * (size_t)row) = (f32x2s){mean, rstd};
#pragma unroll
        for (int i = 0; i < 4; ++i) { const f32x4 y = v[i] * rstd * gv[i] + bv[i];
            if (!stats) *(f32x4*)(op + i * 256 + lane * 4) = y;
            if (xb) { u32x2 w; w.x = pg8::cvt_pk_bf16(y[0], y[1]); w.y = pg8::cvt_pk_bf16(y[2], y[3]); *(u32x2*)(xb + (size_t)row * DM + i * 256 + lane * 4) = w; } }
    }
}

__device__ void mixprep_phase(int l, const bf16_t* Z, bf16_t* pooled, bf16_t* lora_a) {
    const Params& p = fresh_params();
    const size_t gt = (size_t)blockIdx.x * NTHREADS + fresh_tid(), gs = (size_t)gridDim.x * NTHREADS;
    const float* hist_all = p.in[4] + (size_t)l * 16 * 15 * 256;
    for (size_t task = gt; task < (size_t)MROWS * 32; task += gs) {
        const int row = (int)(task >> 5), c8 = (int)(task & 31), col = c8 * 8, w = 2 << (c8 >> 3);
        const bool samp = row >= MP; const int b = samp ? ((row - MP) >> 5) : (row >> 12), t = samp ? ((row - MP) & 31) : (row & 4095);
        float acc[8], u0[8];
#pragma unroll
        for (int j = 0; j < 8; ++j) acc[j] = 0.f;
        for (int d = 0; d < w; ++d) {
            const int tt = t - d;
            if (tt >= 0) { const u32x4 q = *(const u32x4*)(Z + (size_t)(row - d) * NIN + col);
                const float f0 = bf_lo(q.x), f1 = bf_hi(q.x), f2 = bf_lo(q.y), f3 = bf_hi(q.y), f4 = bf_lo(q.z), f5 = bf_hi(q.z), f6 = bf_lo(q.w), f7 = bf_hi(q.w);
                if (d == 0) { u0[0] = f0; u0[1] = f1; u0[2] = f2; u0[3] = f3; u0[4] = f4; u0[5] = f5; u0[6] = f6; u0[7] = f7; }
                acc[0] += f0; acc[1] += f1; acc[2] += f2; acc[3] += f3; acc[4] += f4; acc[5] += f5; acc[6] += f6; acc[7] += f7; }
            else if (samp) { const float* hp = hist_all + ((size_t)b * 15 + (15 + tt)) * 256 + col; const f32x4 a = *(const f32x4*)hp, c = *(const f32x4*)(hp + 4);
                acc[0] += a[0]; acc[1] += a[1]; acc[2] += a[2]; acc[3] += a[3]; acc[4] += c[0]; acc[5] += c[1]; acc[6] += c[2]; acc[7] += c[3]; }
        }
        const float inv = 1.0f / (float)(samp ? w : ((t + 1 < w) ? (t + 1) : w));
        u32x4 o; o.x = pg8::cvt_pk_bf16(acc[0] * inv - u0[0], acc[1] * inv - u0[1]); o.y = pg8::cvt_pk_bf16(acc[2] * inv - u0[2], acc[3] * inv - u0[3]);
        o.z = pg8::cvt_pk_bf16(acc[4] * inv - u0[4], acc[5] * inv - u0[5]); o.w = pg8::cvt_pk_bf16(acc[6] * inv - u0[6], acc[7] * inv - u0[7]);
        *(u32x4*)(pooled + (size_t)row * 256 + col) = o;
        const int T = samp ? 32 : 4096;
        if (t >= T - 15) { float* op = p.out + (samp ? O_PS : O_PP) + (((size_t)l * 16 + b) * 15 + (t - (T - 15))) * 256 + col;
            *(f32x4*)op = (f32x4){u0[0], u0[1], u0[2], u0[3]}; *(f32x4*)(op + 4) = (f32x4){u0[4], u0[5], u0[6], u0[7]}; }
    }
    {
        const float* mu = p.in[18] + (size_t)l * 2560 + 2304;
        for (size_t task = gt; task < (size_t)MROWS * 32; task += gs) {
            const int row = (int)(task >> 5), q8 = (int)(task & 31), col = q8 * 8;
            const bool samp = row >= MP; const int b = samp ? ((row - MP) >> 5) : (row >> 12), t = samp ? ((row - MP) & 31) : (row & 4095);
            const u32x4 q = *(const u32x4*)(Z + (size_t)row * NIN + 256 + 2304 + col);
            float cur[8] = {bf_lo(q.x), bf_hi(q.x), bf_lo(q.y), bf_hi(q.y), bf_lo(q.z), bf_hi(q.z), bf_lo(q.w), bf_hi(q.w)};
            float prv[8];
            if (t > 0) { const u32x4 r = *(const u32x4*)(Z + (size_t)(row - 1) * NIN + 256 + 2304 + col);
                prv[0] = bf_lo(r.x); prv[1] = bf_hi(r.x); prv[2] = bf_lo(r.y); prv[3] = bf_hi(r.y); prv[4] = bf_lo(r.z); prv[5] = bf_hi(r.z); prv[6] = bf_lo(r.w); prv[7] = bf_hi(r.w); }
            else if (samp) { const float* sp = p.in[5] + ((size_t)l * 16 + b) * 2560 + 2304 + col; const f32x4 x = *(const f32x4*)sp, y = *(const f32x4*)(sp + 4);
                prv[0] = x[0]; prv[1] = x[1]; prv[2] = x[2]; prv[3] = x[3]; prv[4] = y[0]; prv[5] = y[1]; prv[6] = y[2]; prv[7] = y[3]; }
            else {
#pragma unroll
                for (int j = 0; j < 8; ++j) prv[j] = 0.f; }
            const f32x4 m0 = *(const f32x4*)(mu + col), m1 = *(const f32x4*)(mu + col + 4);
            float zs[8];
#pragma unroll
            for (int j = 0; j < 8; ++j) { zs[j] = cur[j] + (prv[j] - cur[j]) * (j < 4 ? m0[j] : m1[j - 4]); }
            if (q8 < 8) {
#pragma unroll
                for (int j = 0; j < 8; ++j) zs[j] = ftanh(zs[j]); }
            else if (q8 >= 16) {
#pragma unroll
                for (int j = 0; j < 8; ++j) zs[j] = fsig(zs[j]); }
            u32x4 w; w.x = pg8::cvt_pk_bf16(zs[0], zs[1]); w.y = pg8::cvt_pk_bf16(zs[2], zs[3]); w.z = pg8::cvt_pk_bf16(zs[4], zs[5]); w.w = pg8::cvt_pk_bf16(zs[6], zs[7]);
            *(u32x4*)(lora_a + (size_t)row * 256 + col) = w;
        }
    }
    for (size_t i = gt; i < (size_t)32 * 2560; i += gs) {
        const int s = (int)(i / 2560), c = (int)(i % 2560); const bool samp = s >= 16; const int b = s & 15;
        const int row = samp ? (MP + b * 32 + 31) : (b * 4096 + 4095);
        p.out[(samp ? O_SS : O_SP) + ((size_t)l * 16 + b) * 2560 + c] = __uint_as_float((unsigned)Z[(size_t)row * NIN + 256 + c] << 16);
    }
}

constexpr int TC = 16;
constexpr int RS = 68;
constexpr int MS = 20;
constexpr int NBUF = 4;
constexpr int B_R = 0, B_K = 4352, B_V = 8704, B_A = 13056, B_B = 17408, B_G = 21760, B_Y = 25856, B_PC = 29952, B_BON = 30208, BUFSZ = 30272;
constexpr int SC_W2 = 121088, SC_A2 = 130304, SC_G2 = 139520, SC_CTR = 156928;
constexpr int XS = 72, XGS = 136;
typedef float f32x2 __attribute__((ext_vector_type(2)));
__device__ __forceinline__ float rowsum16(float v) { v += dpp_mov<0xB1>(v); v += dpp_mov<0x4E>(v); v += dpp_mov<0x141>(v); v += dpp_mov<0x140>(v); return v; }
template <int CTRL> __device__ __forceinline__ float dpp_shr1(float v) { return __builtin_bit_cast(float, __builtin_amdgcn_update_dpp(0x3f800000, __builtin_bit_cast(int, v), CTRL, 0xF, 0xF, false)); }
__device__ __forceinline__ float rowprefix_mul(float p) { p *= dpp_shr1<0x111>(p); p *= dpp_shr1<0x112>(p); p *= dpp_shr1<0x114>(p); p *= dpp_shr1<0x118>(p); return p; }
__device__ __forceinline__ void lds_wait_ge(LAS unsigned* ctr, unsigned want) {
    while (__hip_atomic_load(ctr, __ATOMIC_ACQUIRE, __HIP_MEMORY_SCOPE_WORKGROUP) < want) {}
}
__device__ __forceinline__ void prep_bar(LAS unsigned* ctr, unsigned& gen, int lane) {
    gen += 4u;
    if (lane == 0) __hip_atomic_fetch_add(ctr, 1u, __ATOMIC_RELEASE, __HIP_MEMORY_SCOPE_WORKGROUP);
    while (__hip_atomic_load(ctr, __ATOMIC_ACQUIRE, __HIP_MEMORY_SCOPE_WORKGROUP) < gen) {}
}
#define MFMA4(a, b, c) __builtin_amdgcn_mfma_f32_16x16x4f32((a), (b), (c), 0, 0, 0)
#define MFMAB(a, b, c) __builtin_amdgcn_mfma_f32_16x16x32_bf16((a), (b), (c), 0, 0, 0)
__device__ __forceinline__ bf16x8 cvt4z(f32x4 lo) { u32x4 w; w.x = pg8::cvt_pk_bf16(lo[0], lo[1]); w.y = pg8::cvt_pk_bf16(lo[2], lo[3]); w.z = 0u; w.w = 0u; return __builtin_bit_cast(bf16x8, w); }
__device__ __forceinline__ bf16x8 cvt8(f32x4 lo, f32x4 hi) { u32x4 w; w.x = pg8::cvt_pk_bf16(lo[0], lo[1]); w.y = pg8::cvt_pk_bf16(lo[2], lo[3]); w.z = pg8::cvt_pk_bf16(hi[0], hi[1]); w.w = pg8::cvt_pk_bf16(hi[2], hi[3]); return __builtin_bit_cast(bf16x8, w); }

__device__ void scan_phase(int l, const bf16_t* Z, const bf16_t* lora_a, bf16_t* mixin, LAS unsigned char* lds) {
    const Params& p = fresh_params();
    const int tid = fresh_tid(), lane = tid & 63, wave = __builtin_amdgcn_readfirstlane(tid >> 6);
    LAS bf16_t* w2t = (LAS bf16_t*)(lds + SC_W2); LAS bf16_t* a2t = (LAS bf16_t*)(lds + SC_A2); LAS bf16_t* g2t = (LAS bf16_t*)(lds + SC_G2);
    LAS unsigned* ctr = (LAS unsigned*)(lds + SC_CTR);
    const float* mu = p.in[18] + (size_t)l * 2560;
    const int fr = lane & 15, fq = lane >> 4;
    for (int unit = blockIdx.x; unit < 384; unit += gridDim.x) {
        const bool samp = unit >= 192; const int uu = samp ? unit - 192 : unit, b = uu / 12, h = uu % 12;
        const int T = samp ? 32 : 4096, row0 = samp ? (MP + b * 32) : (b * 4096), NC = T / TC;
        __syncthreads();
        for (int i = tid; i < 64 * 64; i += NTHREADS) { const int k = i >> 6, n = i & 63;
            w2t[n * XS + k] = f2bf(p.in[22][((size_t)l * 64 + k) * 768 + h * 64 + n]);
            a2t[n * XS + k] = f2bf(p.in[24][((size_t)l * 64 + k) * 768 + h * 64 + n]); }
        for (int i = tid; i < 128 * 64; i += NTHREADS) { const int k = i >> 6, n = i & 63;
            g2t[n * XGS + k] = f2bf(p.in[25][((size_t)l * 128 + k) * 768 + h * 64 + n]); }
        if (tid < 8) ctr[tid] = 0u;
        __syncthreads();
        if (wave < 4) {
            const int vt = wave;
            f32x4 H0, H1, H2, H3;
            const size_t sbase = ((((size_t)l * 16 + b) * 12 + h) * 64 + vt * 16 + fr) * 64 + 4 * fq;
            if (samp) { const float* sp = p.in[6] + sbase; H0 = *(const f32x4*)sp; H1 = *(const f32x4*)(sp + 16); H2 = *(const f32x4*)(sp + 32); H3 = *(const f32x4*)(sp + 48); }
            else { H0 = (f32x4){0.f, 0.f, 0.f, 0.f}; H1 = H0; H2 = H0; H3 = H0; }
            asm volatile("" : "+v"(H0), "+v"(H1), "+v"(H2), "+v"(H3));
#pragma unroll 1
            for (int c = 0; c < NC; ++c) {
                const int bi = c % NBUF;
                lds_wait_ge(ctr + bi, (unsigned)(c + 1));
                LAS unsigned char* bb = lds + bi * BUFSZ;
                const LAS float* opR = (const LAS float*)(bb + B_R); const LAS float* opK = (const LAS float*)(bb + B_K); const LAS float* opV = (const LAS float*)(bb + B_V);
                const LAS float* opA = (const LAS float*)(bb + B_A); const LAS float* opB = (const LAS float*)(bb + B_B); LAS float* yB = (LAS float*)(bb + B_Y);
                const int ro = fr * RS + 4 * fq;
                const f32x4 a0 = *(const LAS f32x4*)(opA + ro), a1 = *(const LAS f32x4*)(opA + ro + 16), a2 = *(const LAS f32x4*)(opA + ro + 32), a3 = *(const LAS f32x4*)(opA + ro + 48);
                const f32x4 r0 = *(const LAS f32x4*)(opR + ro), r1 = *(const LAS f32x4*)(opR + ro + 16), r2 = *(const LAS f32x4*)(opR + ro + 32), r3 = *(const LAS f32x4*)(opR + ro + 48);
                const f32x4 b0 = *(const LAS f32x4*)(opB + ro), b1 = *(const LAS f32x4*)(opB + ro + 16), b2 = *(const LAS f32x4*)(opB + ro + 32), b3 = *(const LAS f32x4*)(opB + ro + 48);
                const f32x4 k0 = *(const LAS f32x4*)(opK + ro), k1 = *(const LAS f32x4*)(opK + ro + 16), k2 = *(const LAS f32x4*)(opK + ro + 32), k3 = *(const LAS f32x4*)(opK + ro + 48);
                f32x4 W = {0.f, 0.f, 0.f, 0.f}, Y = W;
                f32x4 LA = W, LD = W, KA = W, NbA = W, NkA = W;
                { const bf16x8 hb0 = cvt8(H0, H1), hb1 = cvt8(H2, H3);
                    const bf16x8 fa0 = cvt8(a0, a1), fa1 = cvt8(a2, a3), fr0 = cvt8(r0, r1), fr1 = cvt8(r2, r3);
                    const bf16x8 fb0 = cvt8(b0, b1), fb1 = cvt8(b2, b3), fk0 = cvt8(k0, k1), fk1 = cvt8(k2, k3);
                    W = MFMAB(fa0, hb0, W); W = MFMAB(fa1, hb1, W);
                    Y = MFMAB(fr0, hb0, Y); Y = MFMAB(fr1, hb1, Y);
                    LA = MFMAB(fb0, fa0, LA); LA = MFMAB(fb1, fa1, LA);
                    LD = MFMAB(fa0, fb0, LD); LD = MFMAB(fa1, fb1, LD);
                    KA = MFMAB(fk0, fa0, KA); KA = MFMAB(fk1, fa1, KA);
                    NbA = MFMAB(fb0, fr0, NbA); NbA = MFMAB(fb1, fr1, NbA);
                    NkA = MFMAB(fk0, fr0, NkA); NkA = MFMAB(fk1, fr1, NkA);
                }
#pragma unroll
                for (int j = 0; j < 4; ++j) { const int sA = 4 * fq + j;
                    LA[j] = (sA < fr) ? LA[j] : 0.f; KA[j] = (sA < fr) ? KA[j] : 0.f; NbA[j] = (sA <= fr) ? NbA[j] : 0.f; NkA[j] = (sA <= fr) ? NkA[j] : 0.f;
                    LD[j] = (fr < sA) ? LD[j] : 0.f; }
                const f32x4 Z4 = {0.f, 0.f, 0.f, 0.f};
                const bf16x8 fLA = cvt4z(LA), fLD = cvt4z(LD);
                const f32x4 L2A = MFMAB(fLD, fLA, Z4), L2D = MFMAB(fLA, fLD, Z4);
                const bf16x8 fL2A = cvt4z(L2A), fL2D = cvt4z(L2D);
                const f32x4 L4A = MFMAB(fL2D, fL2A, Z4), L4D = MFMAB(fL2A, fL2D, Z4);
                const bf16x8 fL4A = cvt4z(L4A), fL4D = cvt4z(L4D);
                const f32x4 L8A = MFMAB(fL4D, fL4A, Z4);
                f32x4 Vr;
#pragma unroll
                for (int j = 0; j < 4; ++j) Vr[j] = opV[(4 * fq + j) * RS + vt * 16 + fr];
                W = MFMAB(cvt4z(KA), cvt4z(Vr), W);
                W = MFMAB(fLA, cvt4z(W), W);
                W = MFMAB(fL2A, cvt4z(W), W);
                W = MFMAB(fL4A, cvt4z(W), W);
                W = MFMAB(cvt4z(L8A), cvt4z(W), W);
                const bf16x8 uvb = cvt8(W, Vr);
                Y = MFMAB(cvt8(NbA, NkA), uvb, Y);
#pragma unroll
                for (int j = 0; j < 4; ++j) yB[(4 * fq + j) * 64 + vt * 16 + fr] = Y[j];
                {
                    f32x4 bq0, bq1, bq2, bq3, kq0, kq1, kq2, kq3;
#pragma unroll
                    for (int j = 0; j < 4; ++j) { const int o = (4 * fq + j) * RS + fr;
                        bq0[j] = opB[o]; bq1[j] = opB[o + 16]; bq2[j] = opB[o + 32]; bq3[j] = opB[o + 48];
                        kq0[j] = opK[o]; kq1[j] = opK[o + 16]; kq2[j] = opK[o + 32]; kq3[j] = opK[o + 48]; }
                    H0 = MFMAB(cvt8(bq0, kq0), uvb, H0); H1 = MFMAB(cvt8(bq1, kq1), uvb, H1); H2 = MFMAB(cvt8(bq2, kq2), uvb, H2); H3 = MFMAB(cvt8(bq3, kq3), uvb, H3);
                }
                { const LAS float* pc = (const LAS float*)(bb + B_PC) + 4 * fq;
                    H0 = H0 * *(const LAS f32x4*)pc; H1 = H1 * *(const LAS f32x4*)(pc + 16); H2 = H2 * *(const LAS f32x4*)(pc + 32); H3 = H3 * *(const LAS f32x4*)(pc + 48); }
                if (lane == 0) __hip_atomic_store(ctr + 4 + vt, (unsigned)(c + 1), __ATOMIC_RELEASE, __HIP_MEMORY_SCOPE_WORKGROUP);
            }
            { float* sp = p.out + (samp ? O_WS : O_WP) + sbase; *(f32x4*)sp = H0; *(f32x4*)(sp + 16) = H1; *(f32x4*)(sp + 32) = H2; *(f32x4*)(sp + 48) = H3; }
        } else {
            const int pw = wave - 4;
            __builtin_amdgcn_s_setprio(2);
            const int ecg = lane & 15;
            const int hc4 = l * 768 + h * 64 + 4 * ecg;
            const f32x4 c_kk = *(const f32x4*)(p.in[26] + hc4), c_ka = *(const f32x4*)(p.in[27] + hc4), c_rk = *(const f32x4*)(p.in[28] + hc4);
            const f32x4 c_lg = *(const f32x4*)(p.in[29] + hc4), c_lb = *(const f32x4*)(p.in[30] + hc4);
            f32x4 cw0, ca0;
#pragma unroll
            for (int nt = 0; nt < 4; ++nt) { cw0[nt] = p.in[21][l * 768 + h * 64 + nt * 16 + fr]; ca0[nt] = p.in[23][l * 768 + h * 64 + nt * 16 + fr]; }
            const int cc = lane;
            const bool act1 = cc < 24;
            const int zc = ((act1 ? cc : 23) >> 3) * 768 + h * 64 + (cc & 7) * 8;
            const f32x4 m0 = *(const f32x4*)(mu + zc), m1 = *(const f32x4*)(mu + zc + 4);
            const bf16_t* zbase = Z + (size_t)row0 * NIN + 256 + zc;
            LAS unsigned char* bb = lds + pw * BUFSZ;
            LAS float* opR = (LAS float*)(bb + B_R); LAS float* opK = (LAS float*)(bb + B_K); LAS float* opV = (LAS float*)(bb + B_V);
            LAS float* opA = (LAS float*)(bb + B_A); LAS float* opB = (LAS float*)(bb + B_B); LAS float* gV = (LAS float*)(bb + B_G); LAS float* aL = (LAS float*)(bb + B_Y);
#define LDS_FENCE() asm volatile("s_waitcnt lgkmcnt(0)" ::: "memory")
            f32x4 pv0 = {0.f, 0.f, 0.f, 0.f}, pv1 = pv0;
            if (samp) { const float* sp = p.in[5] + ((size_t)l * 16 + b) * 2560 + zc; pv0 = *(const f32x4*)sp; pv1 = *(const f32x4*)(sp + 4); }
            asm volatile("" : "+v"(pv0), "+v"(pv1));
            u32x4 qq[16], qprev = {0u, 0u, 0u, 0u};
#pragma unroll
            for (int i = 0; i < 16; ++i) qq[i] = qprev;
            { const int c0 = pw < NC ? pw : NC - 1; const bf16_t* zp = zbase + (size_t)(c0 * TC) * NIN;
                qprev = *(const u32x4*)(zp - (c0 > 0 ? NIN : 0));
#pragma unroll
                for (int i = 0; i < 16; ++i) qq[i] = *(const u32x4*)(zp + (size_t)i * NIN); }
#pragma unroll 1
            for (int c = pw; c < NC + NBUF; c += NBUF) {
                if (c >= NBUF) {
                    { const unsigned want = (unsigned)(c - NBUF + 1); lds_wait_ge(ctr + 4, want); lds_wait_ge(ctr + 5, want); lds_wait_ge(ctr + 6, want); lds_wait_ge(ctr + 7, want); }
#pragma unroll 1
                    for (int it = 0; it < 4; ++it) {
                        const int etl = 4 * it + (lane >> 4), o = etl * 64 + 4 * ecg;
                        const f32x4 y = *(const LAS f32x4*)((LAS float*)(bb + B_Y) + o), v = *(const LAS f32x4*)(opV + etl * RS + 4 * ecg), g = *(const LAS f32x4*)(gV + o);
                        const float mean = rowsum16((y[0] + y[1]) + (y[2] + y[3])) * (1.0f / 64.0f);
                        const f32x4 d = y - mean;
                        const float var = rowsum16((d[0] * d[0] + d[1] * d[1]) + (d[2] * d[2] + d[3] * d[3])) * (1.0f / 64.0f);
                        const f32x4 ov = (d * (1.0f / sqrtf(var + 64e-5f)) * c_lg + c_lb + ((LAS float*)(bb + B_BON))[etl] * v) * g;
                        u32x2 w; w.x = pg8::cvt_pk_bf16(ov[0], ov[1]); w.y = pg8::cvt_pk_bf16(ov[2], ov[3]);
                        *(u32x2*)(mixin + ((size_t)row0 + (c - NBUF) * TC + etl) * DM + 256 + h * 64 + 4 * ecg) = w;
                    }
                    LDS_FENCE();
                }
                if (c < NC) {
                const bf16_t* lp = lora_a + ((size_t)row0 + (size_t)c * TC + fr) * 256 + fq * 8;
                const bf16x8 xw0 = *(const bf16x8*)(lp), xw1 = *(const bf16x8*)(lp + 32), xl0 = *(const bf16x8*)(lp + 64), xl1 = *(const bf16x8*)(lp + 96);
                const bf16x8 xg0 = *(const bf16x8*)(lp + 128), xg1 = *(const bf16x8*)(lp + 160), xg2 = *(const bf16x8*)(lp + 192), xg3 = *(const bf16x8*)(lp + 224);
                if (act1) {
                    float prv[8];
                    if (c > 0) { const u32x4 q = qprev;
                        prv[0] = bf_lo(q.x); prv[1] = bf_hi(q.x); prv[2] = bf_lo(q.y); prv[3] = bf_hi(q.y); prv[4] = bf_lo(q.z); prv[5] = bf_hi(q.z); prv[6] = bf_lo(q.w); prv[7] = bf_hi(q.w); }
                    else { prv[0] = pv0[0]; prv[1] = pv0[1]; prv[2] = pv0[2]; prv[3] = pv0[3]; prv[4] = pv1[0]; prv[5] = pv1[1]; prv[6] = pv1[2]; prv[7] = pv1[3]; }
                    LAS float* dst0 = (cc < 8 ? opR : (cc < 16 ? opK : opV)) + (cc & 7) * 8;
#pragma unroll
                    for (int i = 0; i < 16; ++i) {
                        const u32x4 q = qq[i];
                        float cur[8] = {bf_lo(q.x), bf_hi(q.x), bf_lo(q.y), bf_hi(q.y), bf_lo(q.z), bf_hi(q.z), bf_lo(q.w), bf_hi(q.w)};
                        float zs[8];
#pragma unroll
                        for (int j = 0; j < 8; ++j) { zs[j] = cur[j] + (prv[j] - cur[j]) * (j < 4 ? m0[j] : m1[j - 4]); prv[j] = cur[j]; }
                        *(LAS f32x4*)(dst0 + i * RS) = (f32x4){zs[0], zs[1], zs[2], zs[3]}; *(LAS f32x4*)(dst0 + i * RS + 4) = (f32x4){zs[4], zs[5], zs[6], zs[7]};
                    }
                }
                { const int cn = (c + NBUF < NC) ? c + NBUF : NC - 1; const bf16_t* zp = zbase + (size_t)(cn * TC) * NIN;
                    qprev = *(const u32x4*)(zp - (cn > 0 ? NIN : 0));
#pragma unroll
                    for (int i = 0; i < 16; ++i) qq[i] = *(const u32x4*)(zp + (size_t)i * NIN); }
                LDS_FENCE();
#pragma unroll 1
                for (int nt = 0; nt < 4; ++nt) {
                    f32x4 dw = {0.f, 0.f, 0.f, 0.f}, da = dw, dg = dw;
                    { const LAS bf16_t* wp = w2t + (nt * 16 + fr) * XS + fq * 8; const LAS bf16_t* ap = a2t + (nt * 16 + fr) * XS + fq * 8; const LAS bf16_t* gp = g2t + (nt * 16 + fr) * XGS + fq * 8;
                        dw = __builtin_amdgcn_mfma_f32_16x16x32_bf16(xw0, *(const LAS bf16x8*)wp, dw, 0, 0, 0); dw = __builtin_amdgcn_mfma_f32_16x16x32_bf16(xw1, *(const LAS bf16x8*)(wp + 32), dw, 0, 0, 0);
                        da = __builtin_amdgcn_mfma_f32_16x16x32_bf16(xl0, *(const LAS bf16x8*)ap, da, 0, 0, 0); da = __builtin_amdgcn_mfma_f32_16x16x32_bf16(xl1, *(const LAS bf16x8*)(ap + 32), da, 0, 0, 0);
                        dg = __builtin_amdgcn_mfma_f32_16x16x32_bf16(xg0, *(const LAS bf16x8*)gp, dg, 0, 0, 0); dg = __builtin_amdgcn_mfma_f32_16x16x32_bf16(xg1, *(const LAS bf16x8*)(gp + 32), dg, 0, 0, 0);
                        dg = __builtin_amdgcn_mfma_f32_16x16x32_bf16(xg2, *(const LAS bf16x8*)(gp + 64), dg, 0, 0, 0); dg = __builtin_amdgcn_mfma_f32_16x16x32_bf16(xg3, *(const LAS bf16x8*)(gp + 96), dg, 0, 0, 0); }
                    const float w0n = nt == 0 ? cw0[0] : nt == 1 ? cw0[1] : nt == 2 ? cw0[2] : cw0[3], a0n = nt == 0 ? ca0[0] : nt == 1 ? ca0[1] : nt == 2 ? ca0[2] : ca0[3];
                    f32x4 e, E = {0.f, 0.f, 0.f, 0.f};
#pragma unroll
                    for (int j = 0; j < 4; ++j) e[j] = -0.8750402888f * fsig(w0n + dw[j]);
#pragma unroll
                    for (int j = 0; j < 4; ++j) E = MFMA4((4 * fq + j <= fr) ? 1.0f : 0.0f, e[j], E);
#pragma unroll
                    for (int j = 0; j < 4; ++j) { const int t = 4 * fq + j, n = nt * 16 + fr;
                        const float P = __builtin_amdgcn_exp2f(E[j]);
                        opB[t * RS + n] = P; opA[t * RS + n] = __builtin_amdgcn_exp2f(E[j] - e[j]);
                        if (t == 15) ((LAS float*)(bb + B_PC))[n] = P;
                        aL[t * 64 + n] = fsig(a0n + da[j]); gV[t * 64 + n] = dg[j]; }
                }
                LDS_FENCE();
#pragma unroll 1
                for (int it = 0; it < 4; ++it) {
                    const int etl = 4 * it + (lane >> 4), o = etl * RS + 4 * ecg;
                    const f32x4 kr = *(const LAS f32x4*)(opK + o), a = *(const LAS f32x4*)(aL + etl * 64 + 4 * ecg), r = *(const LAS f32x4*)(opR + o);
                    const f32x4 P = *(const LAS f32x4*)(opB + o), Pex = *(const LAS f32x4*)(opA + o);
                    f32x4 kk = kr * c_kk;
                    const float nn = rowsum16((kk[0] * kk[0] + kk[1] * kk[1]) + (kk[2] * kk[2] + kk[3] * kk[3]));
                    kk = kk * (1.0f / fmaxf(sqrtf(nn), 1e-12f));
                    const f32x4 kp = kr * (1.0f + (a - 1.0f) * c_ka);
                    f32x4 inv;
#pragma unroll
                    for (int j = 0; j < 4; ++j) inv[j] = __builtin_amdgcn_rcpf(P[j]);
                    *(LAS f32x4*)(opK + o) = kp * inv; *(LAS f32x4*)(opA + o) = -kk * Pex; *(LAS f32x4*)(opB + o) = kk * a * inv; *(LAS f32x4*)(opR + o) = r * P;
                    const f32x4 rb = r * kp * c_rk;
                    const float bs = rowsum16((rb[0] + rb[1]) + (rb[2] + rb[3]));
                    if (ecg == 0) ((LAS float*)(bb + B_BON))[etl] = bs;
                }
                LDS_FENCE();
                LDS_FENCE();
                if (lane == 0) __hip_atomic_store(ctr + pw, (unsigned)(c + 1), __ATOMIC_RELEASE, __HIP_MEMORY_SCOPE_WORKGROUP);
                }
            }
            __builtin_amdgcn_s_setprio(0);
        }
#undef LDS_FENCE
    }
    __syncthreads();
}
#undef MFMA4

#define XB_TMO      128
#define XB_XCNT(j)  (256  + 64 * (j))
#define XB_XSUB(j)  (1280 + 64 * (j))
#define XB_XGEN(j)  (2304 + 64 * (j))
#define XB_TOP      3328
#define XB_TOPGEN   3392
#define XCD_BAR_WORDS 3456
#define XB_SPIN_CAP (1u << 18)

__device__ __forceinline__ unsigned xb_ld(unsigned* p)              { return __hip_atomic_load(p, __ATOMIC_RELAXED, __HIP_MEMORY_SCOPE_AGENT); }
__device__ __forceinline__ unsigned xb_add(unsigned* p, unsigned v) { return __hip_atomic_fetch_add(p, v, __ATOMIC_RELAXED, __HIP_MEMORY_SCOPE_AGENT); }
__device__ __forceinline__ unsigned xb_xcc_id() { return (unsigned)__builtin_amdgcn_s_getreg((3 << 11) | 20) & 0xFu; }
#define XB_SPIN(cond, bar) do { unsigned _sp = 0; while (cond) { __builtin_amdgcn_s_sleep(1); \
    if ((++_sp & 255u) == 0u) { if (xb_ld(&(bar)[XB_TMO])) break; if (_sp > XB_SPIN_CAP) { atomicAdd(&(bar)[XB_TMO], 1u); break; } } } } while (0)

struct XcdBarrier {
    unsigned* bar; unsigned x;
    volatile LAS unsigned* st;
};

__device__ __forceinline__ XcdBarrier xcd_barrier_post(unsigned* bar, volatile LAS unsigned* st) {
    XcdBarrier b; b.bar = bar; b.x = xb_xcc_id(); b.st = st;
    if (threadIdx.x == 0) (void)xb_add(&bar[XB_XCNT(b.x)], 1u);
    return b;
}
__device__ __forceinline__ void xcd_barrier_complete(unsigned* bar, unsigned x, unsigned& nloc, unsigned& nx) {
    const unsigned G = gridDim.x * gridDim.y * gridDim.z;
    unsigned sum, cnt, mine, sp = 0u;
    for (;;) {
        sum = 0u; cnt = 0u; mine = 0u;
#pragma unroll
        for (unsigned j = 0; j < 16; ++j) { const unsigned c = xb_ld(&bar[XB_XCNT(j)]); sum += c; cnt += (c > 0u) ? 1u : 0u; mine = (j == x) ? c : mine; }
        if (sum == G) break;
        __builtin_amdgcn_s_sleep(1);
        if ((++sp & 255u) == 0u) { if (xb_ld(&bar[XB_TMO])) break; if (sp > XB_SPIN_CAP) { atomicAdd(&bar[XB_TMO], 1u); break; } }
    }
    nloc = mine > 0u ? mine : 1u; nx = cnt > 0u ? cnt : 1u;
}

__device__ __forceinline__ void xcd_barrier(const XcdBarrier& b) {
    asm volatile("s_waitcnt vmcnt(0)" ::: "memory");
    __syncthreads();
    if (threadIdx.x == 0) {
        unsigned* bar = b.bar;
        __builtin_amdgcn_s_waitcnt(0);
        unsigned nloc = b.st[0], nx = b.st[1];
        if (nloc == 0u) { xcd_barrier_complete(bar, b.x, nloc, nx); b.st[0] = nloc; b.st[1] = nx; }
        const unsigned old = xb_add(&bar[XB_XSUB(b.x)], 1u);
        const unsigned gen = old / nloc;
        if (old + 1u == (gen + 1u) * nloc) {
            __builtin_amdgcn_fence(__ATOMIC_RELEASE, "agent");
            asm volatile("s_waitcnt vmcnt(0)" ::: "memory");
            const unsigned og = xb_add(&bar[XB_TOP], 1u);
            const unsigned tg = og / nx;
            if (og + 1u == (tg + 1u) * nx) xb_add(&bar[XB_TOPGEN], 1u);
            else XB_SPIN(xb_ld(&bar[XB_TOPGEN]) == tg, bar);
            __builtin_amdgcn_fence(__ATOMIC_ACQUIRE, "agent");
            xb_add(&bar[XB_XGEN(b.x)], 1u);
            asm volatile("s_waitcnt vmcnt(0)" ::: "memory");
        } else {
            XB_SPIN(xb_ld(&bar[XB_XGEN(b.x)]) == gen, bar);
            __builtin_amdgcn_fence(__ATOMIC_ACQUIRE, "agent");
            asm volatile("s_waitcnt vmcnt(0)" ::: "memory");
        }
    }
    __syncthreads();
}

template <class Epi> __device__ __forceinline__ void run_gemm(LAS unsigned char* lds, const bf16_t* A, const bf16_t* Bt, int N, int K, const Epi E, int rot, int gsub = 0, int csub = 0) {
    asm volatile("" : "+s"(K), "+s"(N));
    pg8::Gemm g{A, Bt, MROWS, N, K}; pg8::StaticOrder S;
    if (gsub > 0) S.init(MROWS, N, gsub, csub);
    else S.init(MROWS, N, (int)gridDim.x, (int)((blockIdx.x + rot) % gridDim.x));
    pg8::gemm_phase<Epi, pg8::StaticOrder, false>((PG8_LAS unsigned char*)lds, g, S, E, nullptr);
}

template <class Epi> __device__ __forceinline__ void run_gemm_range(LAS unsigned char* lds, const bf16_t* A, const bf16_t* Bt, int N, int K, const Epi E, int i0, int i1) {
    asm volatile("" : "+s"(K), "+s"(N), "+s"(i0), "+s"(i1));
    pg8::Gemm g{A, Bt, MROWS, N, K}; pg8::RangeOrder S; S.init(MROWS, N, (int)gridDim.x, (int)blockIdx.x); S.i0 = i0; S.i1 = i1;
    pg8::gemm_phase<Epi, pg8::RangeOrder, false>((PG8_LAS unsigned char*)lds, g, S, E, nullptr);
}
#define COMMA ,
#define GEMM_THEN_LN(EPI_DECL, AOP, BOP, KK, LNG, LNB, XBO, OUTP, OUTS, STATSP) do { \
    if (gridDim.x == 256) { \
        _Pragma("unroll 1") for (int part = 0; part < 2; ++part) { \
            if (part == 0 || blockIdx.x < 8) { EPI_DECL; run_gemm_range(lds, AOP, BOP, DM, KK, E, part * 4, part ? 5 : 4); } \
            else ln_tiles(0, R, LNG, LNB, XBO, OUTP, OUTS, STATSP); \
            xcd_barrier(xbar); } \
        ln_tiles(1, R, LNG, LNB, XBO, OUTP, OUTS, STATSP); \
    } else { { EPI_DECL; run_gemm(lds, AOP, BOP, DM, KK, E, 0); } xcd_barrier(xbar); ln_phase(R, LNG, LNB, XBO, OUTP, OUTS, STATSP); } } while (0)
__global__ void __launch_bounds__(NTHREADS, 2) mega_fwd(Params p_unused) {
    extern __shared__ __attribute__((aligned(16))) unsigned char lds_raw[];
    LAS unsigned char* lds = (LAS unsigned char*)lds_raw;
    cg::grid_group grid = cg::this_grid();
    unsigned char* ws = fresh_params().ws;
    bf16_t* WT = (bf16_t*)(ws + OFF_WT); float* R = (float*)(ws + OFF_R); bf16_t* XB = (bf16_t*)(ws + OFF_XB); bf16_t* HZ = (bf16_t*)(ws + OFF_HZ);
    bf16_t* PB = (bf16_t*)(ws + OFF_PB); bf16_t* PPb = (bf16_t*)(ws + OFF_PP); bf16_t* POOLED = PPb; float* STATS = (float*)(ws + OFF_STATS); const float* GB = (const float*)(ws + OFF_GB);

    if (threadIdx.x < 4) ((LAS unsigned*)(lds + LDS_XB))[threadIdx.x] = 0u;
    __syncthreads();
    const XcdBarrier xbar = xcd_barrier_post((unsigned*)(ws + OFF_BAR), (volatile LAS unsigned*)(lds + LDS_XB));
    prologue(lds);
    grid.sync();
    for (int l = 0; l < 2; ++l) {
        const Params& p = fresh_params();
        const bf16_t* W = WT + (size_t)l * WT_LAYER;
        { pg8::EpiSwiglu E{HZ, DFF}; run_gemm(lds, XB, W + WT_FFN1IN, 2 * DFF, DM, E, 0); }
        xcd_barrier(xbar);
        if (l == 0) GEMM_THEN_LN(pg8::EpiResidIn E{p.in[0] COMMA p.in[1] - (size_t)MP * DM COMMA MP COMMA R COMMA ALPHA_F COMMA 0.5f}, HZ, W + WT_FFN1OUT, DFF, p.in[7] + l * DM, p.in[8] + l * DM, XB, nullptr, nullptr, STATS);
        else GEMM_THEN_LN(pg8::EpiResidLN<false COMMA true> E{R COMMA nullptr COMMA (int)(OFF_STATS - OFF_R) COMMA (int)(OFF_GB - OFF_R) + 2 * 8192}, HZ, W + WT_FFN1OUT, DFF, p.in[7] + l * DM, p.in[8] + l * DM, XB, nullptr, nullptr, STATS);
        xcd_barrier(xbar);
        { pg8::EpiStoreBf16 E{HZ, NIN, nullptr}; run_gemm(lds, XB, W + WT_WIN, NIN, DM, E, 0); }
        xcd_barrier(xbar);
        mixprep_phase(l, HZ, POOLED, POOLED + (size_t)MROWS * 256);
        xcd_barrier(xbar);
        if (gridDim.x == 256) { if (blockIdx.x >= 192) { pg8::EpiStoreBf16 E{XB, DM, p.in[20] + l * 256}; run_gemm(lds, POOLED, W + WT_POOL, 256, 256, E, 0, 64, (int)blockIdx.x - 192); } }
        else { pg8::EpiStoreBf16 E{XB, DM, p.in[20] + l * 256}; run_gemm(lds, POOLED, W + WT_POOL, 256, 256, E, 0); }
        scan_phase(l, HZ, POOLED + (size_t)MROWS * 256, XB, lds);
        xcd_barrier(xbar);
        GEMM_THEN_LN(pg8::EpiResidLN<false COMMA false> E{R COMMA nullptr COMMA (int)(OFF_STATS - OFF_R) COMMA (int)(OFF_GB - OFF_R) + (l * 3 + 0) * 8192}, XB, W + WT_WOUT, DM, p.in[9] + l * DM, p.in[10] + l * DM, XB, nullptr, nullptr, STATS);
        xcd_barrier(xbar);
        { pg8::EpiSwiglu E{HZ, DFF}; run_gemm(lds, XB, W + WT_FFN2IN, 2 * DFF, DM, E, 0); }
        xcd_barrier(xbar);
        { pg8::EpiResidLN<true, true> E{R, XB, (int)(OFF_STATS - OFF_R), (int)(OFF_GB - OFF_R) + (l * 3 + 1) * 8192}; run_gemm(lds, HZ, W + WT_FFN2OUT, DM, DFF, E, 0); }
        { pg8::EpiStoreBf16 E{PPb, DM, nullptr}; const bool sub = gridDim.x == 256;
          if (!sub || blockIdx.x >= 8) run_gemm(lds, PB + (size_t)l * MROWS * 256, W + WT_PLE, DM, 256, E, sub ? 0 : 128, sub ? 248 : 0, sub ? (int)blockIdx.x - 8 : 0); }
        xcd_barrier(xbar);
        GEMM_THEN_LN(pg8::EpiGate E{R COMMA PPb COMMA p.in[33] + l * DM COMMA DM}, XB, W + WT_GATE, DM, p.in[11] + l * DM, p.in[12] + l * DM, (l == 0 ? XB : (bf16_t*)nullptr), (l == 0 ? (float*)nullptr : p.out + O_YP), (l == 0 ? (float*)nullptr : p.out + O_YS), (l == 0 ? STATS : (float*)nullptr));
        if (l == 0) xcd_barrier(xbar);
    }
}

extern "C" void kernel_launch(void* const* d_in, const int* in_sizes, int n_in, void* d_out, int out_size, void* d_ws, size_t ws_size, hipStream_t stream) {
    static int grid_blocks = 0;
    if (grid_blocks == 0) {
        if (n_in != 35 || ws_size < WS_END) { fprintf(stderr, "kernel_launch: expected 35 inputs and >= %zu bytes of workspace, got %d and %zu\n", (size_t)WS_END, n_in, ws_size); grid_blocks = -1; return; }
        int dev = 0, cus = 0, per_cu = 0;
        hipGetDevice(&dev);
        hipDeviceGetAttribute(&cus, hipDeviceAttributeMultiprocessorCount, dev);
        if (hipFuncSetAttribute((const void*)mega_fwd, hipFuncAttributeMaxDynamicSharedMemorySize, LDS_BYTES) != hipSuccess) { fprintf(stderr, "kernel_launch: hipFuncSetAttribute failed\n"); (void)hipGetLastError(); }
        if (hipOccupancyMaxActiveBlocksPerMultiprocessor(&per_cu, (const void*)mega_fwd, NTHREADS, LDS_BYTES) != hipSuccess || per_cu < 1) { fprintf(stderr, "kernel_launch: occupancy query gave %d\n", per_cu); per_cu = 1; (void)hipGetLastError(); }
        grid_blocks = cus * per_cu;
    }
    if (grid_blocks < 0) return;
    Params p{};
    for (int i = 0; i < 35; ++i) p.in[i] = (const float*)d_in[i];
    p.out = (float*)d_out; p.ws = (unsigned char*)d_ws;
    (void)hipMemsetAsync((char*)d_ws + OFF_BAR, 0, 13824, stream);
    void* args[] = {&p};
    hipError_t e = hipLaunchCooperativeKernel((const void*)mega_fwd, dim3(grid_blocks), dim3(NTHREADS), args, LDS_BYTES, stream);
    if (e != hipSuccess) fprintf(stderr, "cooperative launch failed: %s (grid %d)\n", hipGetErrorString(e), grid_blocks);
}
```
